# Optimizing an MI355X kernel written in HIP

```python
import jax, jax.numpy as jnp
from jax import lax
import numpy as np

D_MODEL = 4096
BATCH = 2
SEQ = 8192
DEPTH = 1

MEM_LEN = 256
RMS_EPS = 1e-6

GLA_HEADS = 8
GLA_DK = 256
GLA_DV = 512
GLA_RANK = 16
GLA_TAU = 16.0
GLA_CHUNK = 64
GLA_QK = GLA_HEADS * GLA_DK
GLA_V = GLA_HEADS * GLA_DV

SWA_HEADS = 64
SWA_KV_HEADS = 8
SWA_GROUP = SWA_HEADS // SWA_KV_HEADS
SWA_HD = 64
SWA_WINDOW = 128
SWA_BLOCK = 128
SWA_Q = SWA_HEADS * SWA_HD
SWA_KV = SWA_KV_HEADS * SWA_HD

MEM_HEADS = 4
MEM_HD = D_MODEL // MEM_HEADS
MEM_Q = MEM_HEADS * MEM_HD

N_BRANCH = 3

PEER_HEADS = 8
PEER_NKEYS = 128
PEER_N = PEER_NKEYS * PEER_NKEYS
PEER_DQ = 256
PEER_TOPK = 16
PEER_CHUNK = 128

SPLITS = (GLA_QK, GLA_QK, GLA_V, GLA_V, GLA_RANK, SWA_Q, SWA_KV, SWA_KV, MEM_Q, N_BRANCH * D_MODEL)
D_IN = GLA_QK + GLA_QK + GLA_V + GLA_V + GLA_RANK + SWA_Q + SWA_KV + SWA_KV + MEM_Q + N_BRANCH * D_MODEL

kernel_name = 'hybrid_gla_swa_mem_peer_layer'


def rms_norm(x, gain):
    xf = x.astype(jnp.float32)
    y = xf * lax.rsqrt(jnp.mean(xf * xf, axis=-1, keepdims=True) + RMS_EPS)
    return (y * gain.astype(jnp.float32)).astype(x.dtype)


def gla_chunked(q, k, v, log_a):
    B, S = q.shape[0], q.shape[1]
    nc = S // GLA_CHUNK

    def to_chunks(t):
        return t.reshape(B, nc, GLA_CHUNK, t.shape[2], t.shape[3]).transpose(1, 0, 3, 2, 4)

    qc, kc, vc, ac = to_chunks(q), to_chunks(k), to_chunks(v), to_chunks(log_a)
    causal = jnp.tril(jnp.ones((GLA_CHUNK, GLA_CHUNK), dtype=bool))

    def step(state, inp):
        qi, ki, vi, ai = inp
        qf, kf, vf = qi.astype(jnp.float32), ki.astype(jnp.float32), vi.astype(jnp.float32)
        b = jnp.cumsum(ai.astype(jnp.float32), axis=2)
        b_last = b[:, :, -1:, :]
        o_inter = jnp.einsum('bhcd,bhde->bhce', qf * jnp.exp(b), state)
        diff = b[:, :, :, None, :] - b[:, :, None, :, :]
        decay = jnp.exp(jnp.where(causal[None, None, :, :, None], diff, -jnp.inf))
        attn = jnp.einsum('bhijd,bhjd->bhij', qf[:, :, :, None, :] * decay, kf)
        o = o_inter + jnp.einsum('bhij,bhje->bhie', attn, vf)
        k_dec = kf * jnp.exp(b_last - b)
        state = jnp.exp(b_last[:, :, 0, :])[..., None] * state + jnp.einsum('bhcd,bhce->bhde', k_dec, vf)
        return state, o

    state0 = jnp.zeros((B, GLA_HEADS, GLA_DK, GLA_DV), jnp.float32)
    _, o = lax.scan(step, state0, (qc, kc, vc, ac))
    return o.transpose(1, 0, 3, 2, 4).reshape(B, S, GLA_HEADS, GLA_DV).astype(v.dtype)


def sliding_window_attention(q, k, v, sinks):
    B, S = q.shape[0], q.shape[1]
    nb = S // SWA_BLOCK
    qb = q.reshape(B, nb, SWA_BLOCK, SWA_KV_HEADS, SWA_GROUP, SWA_HD)
    kb = k.reshape(B, nb, SWA_BLOCK, SWA_KV_HEADS, SWA_HD)
    vb = v.reshape(B, nb, SWA_BLOCK, SWA_KV_HEADS, SWA_HD)

    def with_prev(t):
        prev = jnp.concatenate([jnp.zeros_like(t[:, :1]), t[:, :-1]], axis=1)
        return jnp.concatenate([prev, t], axis=2)

    kw, vw = with_prev(kb), with_prev(vb)
    q_loc = jnp.arange(SWA_BLOCK)[:, None] + SWA_BLOCK
    k_loc = jnp.arange(2 * SWA_BLOCK)[None, :]
    band = (k_loc <= q_loc) & (q_loc - k_loc < SWA_WINDOW)
    sink = sinks.astype(jnp.float32).reshape(SWA_KV_HEADS, SWA_GROUP)[None, :, :, None, None]
    scale = SWA_HD ** -0.5

    def block_attn(args):
        qx, kx, vx, blk = args
        s = jnp.einsum('bqhgd,bkhd->bhgqk', qx, kx).astype(jnp.float32) * scale
        mask = band & (k_loc + (blk - 1) * SWA_BLOCK >= 0)
        s = jnp.where(mask, s, -jnp.inf)
        m = jnp.maximum(jnp.max(s, axis=-1, keepdims=True), sink)
        p = jnp.exp(s - m)
        denom = jnp.sum(p, axis=-1, keepdims=True) + jnp.exp(sink - m)
        return jnp.einsum('bhgqk,bkhd->bqhgd', (p / denom).astype(vx.dtype), vx)

    o = lax.map(block_attn, (jnp.moveaxis(qb, 1, 0), jnp.moveaxis(kw, 1, 0), jnp.moveaxis(vw, 1, 0), jnp.arange(nb)))
    return jnp.moveaxis(o, 0, 1).reshape(B, S, SWA_Q)


def memory_cross_attention(q, k, v):
    B, S = q.shape[0], q.shape[1]
    s = jnp.einsum('bshd,bmhd->bhsm', q, k).astype(jnp.float32) * (MEM_HD ** -0.5)
    p = jax.nn.softmax(s, axis=-1).astype(v.dtype)
    return jnp.einsum('bhsm,bmhd->bshd', p, v).reshape(B, S, MEM_Q)


def mixer_block(x, mem, norm_mix, w_in, gla_w_gate_up, gla_gate_bias, gla_out_norm,
                swa_q_norm, swa_k_norm, swa_sinks, mem_norm, w_mem_kv, mem_q_norm, mem_k_norm,
                w_branch_gla, w_branch_swa, w_branch_mem, w_out):
    B, S = x.shape[0], x.shape[1]
    xn = rms_norm(x, norm_mix)
    proj = xn @ w_in
    offsets = np.cumsum(SPLITS)[:-1].tolist()
    gq, gk, gv, gr, glr, sq, sk, sv, mq, gate_logits = jnp.split(proj, offsets, axis=-1)

    q_a = gq.reshape(B, S, GLA_HEADS, GLA_DK) * (GLA_DK ** -0.5)
    k_a = gk.reshape(B, S, GLA_HEADS, GLA_DK)
    v_a = gv.reshape(B, S, GLA_HEADS, GLA_DV)
    log_a = jax.nn.log_sigmoid((glr @ gla_w_gate_up + gla_gate_bias).astype(jnp.float32)) / GLA_TAU
    o_a = gla_chunked(q_a, k_a, v_a, log_a.reshape(B, S, GLA_HEADS, GLA_DK))
    o_a = rms_norm(o_a, gla_out_norm) * jax.nn.silu(gr.reshape(B, S, GLA_HEADS, GLA_DV))
    o_a = o_a.reshape(B, S, GLA_V)

    q_b = rms_norm(sq.reshape(B, S, SWA_HEADS, SWA_HD), swa_q_norm).reshape(B, S, SWA_KV_HEADS, SWA_GROUP, SWA_HD)
    k_b = rms_norm(sk.reshape(B, S, SWA_KV_HEADS, SWA_HD), swa_k_norm)
    v_b = sv.reshape(B, S, SWA_KV_HEADS, SWA_HD)
    o_b = sliding_window_attention(q_b, k_b, v_b, swa_sinks)

    kv_m = rms_norm(mem, mem_norm) @ w_mem_kv
    M = mem.shape[1]
    k_m, v_m = jnp.split(kv_m, 2, axis=-1)
    q_c = rms_norm(mq.reshape(B, S, MEM_HEADS, MEM_HD), mem_q_norm)
    k_c = rms_norm(k_m.reshape(B, M, MEM_HEADS, MEM_HD), mem_k_norm)
    o_c = memory_cross_attention(q_c, k_c, v_m.reshape(B, M, MEM_HEADS, MEM_HD))

    g = jax.nn.sigmoid(gate_logits.astype(jnp.float32)).astype(x.dtype).reshape(B, S, N_BRANCH, D_MODEL)
    mix = g[:, :, 0] * (o_a @ w_branch_gla) + g[:, :, 1] * (o_b @ w_branch_swa) + g[:, :, 2] * (o_c @ w_branch_mem)
    return x + mix @ w_out


def peer_ffn(x, w_q, sub_keys, u_table, v_table):
    B, S, D = x.shape
    T = B * S
    xt = x.reshape(T, D)
    q = (xt @ w_q).reshape(T, PEER_HEADS, 2, PEER_DQ // 2)
    s = jnp.einsum('thpd,hpnd->thpn', q, sub_keys).astype(jnp.float32)
    top_s, top_i = lax.top_k(s, PEER_TOPK)
    cand = top_s[:, :, 0, :, None] + top_s[:, :, 1, None, :]
    best_s, best_c = lax.top_k(cand.reshape(T, PEER_HEADS, PEER_TOPK * PEER_TOPK), PEER_TOPK)
    i1 = jnp.take_along_axis(top_i[:, :, 0], best_c // PEER_TOPK, axis=-1)
    i2 = jnp.take_along_axis(top_i[:, :, 1], best_c % PEER_TOPK, axis=-1)
    expert = i1 * PEER_NKEYS + i2
    gate = jax.nn.softmax(best_s, axis=-1).astype(x.dtype)
    nchunk = T // PEER_CHUNK

    def chunk_fn(args):
        xc, ec, gc = args
        act = jax.nn.gelu(jnp.einsum('chkd,cd->chk', u_table[ec], xc), approximate=False)
        return jnp.einsum('chk,chkd->cd', gc * act, v_table[ec])

    y = lax.map(chunk_fn, (xt.reshape(nchunk, PEER_CHUNK, D),
                           expert.reshape(nchunk, PEER_CHUNK, PEER_HEADS, PEER_TOPK),
                           gate.reshape(nchunk, PEER_CHUNK, PEER_HEADS, PEER_TOPK)))
    return y.reshape(B, S, D)


def setup_inputs(seed: int = 0) -> dict:
    key = jax.random.key(seed)
    ks = jax.random.split(key, 24)
    L = DEPTH
    f32 = jnp.float32

    def dense(k, shape, fan_in):
        return jax.random.normal(k, shape, f32) * (fan_in ** -0.5)

    def gain(k, shape):
        return 1.0 + 0.02 * jax.random.normal(k, shape, f32)

    return {
        'x': jax.random.normal(ks[0], (BATCH, SEQ, D_MODEL), f32),
        'mem': jax.random.normal(ks[1], (BATCH, MEM_LEN, D_MODEL), f32),
        'norm_mix': gain(ks[2], (L, D_MODEL)),
        'w_in': dense(ks[3], (L, D_MODEL, D_IN), D_MODEL),
        'gla_w_gate_up': dense(ks[4], (L, GLA_RANK, GLA_QK), GLA_RANK),
        'gla_gate_bias': 0.1 * jax.random.normal(ks[5], (L, GLA_QK), f32),
        'gla_out_norm': gain(ks[6], (L, GLA_HEADS, GLA_DV)),
        'swa_q_norm': gain(ks[7], (L, SWA_HD)),
        'swa_k_norm': gain(ks[8], (L, SWA_HD)),
        'swa_sinks': 0.5 * jax.random.normal(ks[9], (L, SWA_HEADS), f32),
        'mem_norm': gain(ks[10], (L, D_MODEL)),
        'w_mem_kv': dense(ks[11], (L, D_MODEL, 2 * MEM_Q), D_MODEL),
        'mem_q_norm': gain(ks[12], (L, MEM_HD)),
        'mem_k_norm': gain(ks[13], (L, MEM_HD)),
        'w_branch_gla': dense(ks[14], (L, GLA_V, D_MODEL), GLA_V),
        'w_branch_swa': dense(ks[15], (L, SWA_Q, D_MODEL), SWA_Q),
        'w_branch_mem': dense(ks[16], (L, MEM_Q, D_MODEL), MEM_Q),
        'w_out': dense(ks[17], (L, D_MODEL, D_MODEL), D_MODEL),
        'norm_ffn': gain(ks[18], (L, D_MODEL)),
        'peer_w_q': dense(ks[19], (L, D_MODEL, PEER_HEADS * PEER_DQ), D_MODEL),
        'peer_sub_keys': dense(ks[20], (L, PEER_HEADS, 2, PEER_NKEYS, PEER_DQ // 2), PEER_DQ // 2),
        'peer_u': dense(ks[21], (L, PEER_N, D_MODEL), D_MODEL),
        'peer_v': 0.5 * jax.random.normal(ks[22], (L, PEER_N, D_MODEL), f32),
    }


def reference(x, mem, norm_mix, w_in, gla_w_gate_up, gla_gate_bias, gla_out_norm,
              swa_q_norm, swa_k_norm, swa_sinks, mem_norm, w_mem_kv, mem_q_norm, mem_k_norm,
              w_branch_gla, w_branch_swa, w_branch_mem, w_out, norm_ffn,
              peer_w_q, peer_sub_keys, peer_u, peer_v):
    h = x
    for l in range(DEPTH):
        h = mixer_block(h, mem, norm_mix[l], w_in[l], gla_w_gate_up[l], gla_gate_bias[l], gla_out_norm[l],
                        swa_q_norm[l], swa_k_norm[l], swa_sinks[l], mem_norm[l], w_mem_kv[l],
                        mem_q_norm[l], mem_k_norm[l], w_branch_gla[l], w_branch_swa[l], w_branch_mem[l], w_out[l])
        h = h + peer_ffn(rms_norm(h, norm_ffn[l]), peer_w_q[l], peer_sub_keys[l], peer_u[l], peer_v[l])
    return h
```

```cpp
#include <hip/hip_runtime.h>
#include <cstdio>
#include <cstdint>

#define GAS __attribute__((address_space(1)))
#define LAS __attribute__((address_space(3)))
typedef unsigned short bf16;
typedef unsigned v4u __attribute__((ext_vector_type(4)));
typedef unsigned v2u __attribute__((ext_vector_type(2)));
typedef float f32x4 __attribute__((ext_vector_type(4)));
typedef float f32x2 __attribute__((ext_vector_type(2)));
typedef short bf16x8 __attribute__((ext_vector_type(8)));
typedef unsigned char uchar;

constexpr int D = 4096, BATCH = 2, SEQ = 8192, T = BATCH * SEQ, MEM = 256;
constexpr int DIN = 33808;
constexpr int NV = 34048;
constexpr float EPS = 1e-6f;
constexpr int NWAVES = 8, NTHR = 512;

constexpr size_t MiB = 1u << 20;
constexpr size_t WS_CTL = 0, CTL_ZERO_BYTES = 1 * MiB;
constexpr size_t WS_WIN_T = 1 * MiB;
constexpr size_t WS_MIXF = WS_WIN_T;
constexpr size_t WS_WKV_T = WS_WIN_T + 266 * MiB;
constexpr size_t WS_WBR_T = WS_WKV_T + 64 * MiB;
constexpr size_t WS_WOUT_T = WS_WBR_T + 96 * MiB;
constexpr size_t WS_WQ_T = WS_WOUT_T + 32 * MiB;
constexpr size_t WS_U = WS_WIN_T;
constexpr size_t WS_VT = WS_WIN_T + 128 * MiB;
constexpr size_t WS_XN = WS_WQ_T + 16 * MiB;
constexpr size_t WS_MEMN = WS_XN + 128 * MiB;
constexpr size_t WS_KVM = WS_MEMN + 4 * MiB;
constexpr size_t WS_GQ = WS_KVM + 8 * MiB;
constexpr size_t WS_GK = WS_GQ + 64 * MiB;
constexpr size_t WS_QP = WS_GQ;
constexpr size_t WS_GV = WS_GK + 64 * MiB;
constexpr size_t WS_GR = WS_GV + 128 * MiB;
constexpr size_t WS_SQ = WS_GR + 128 * MiB;
constexpr size_t WS_SK = WS_SQ + 128 * MiB;
constexpr size_t WS_SV = WS_SK + 16 * MiB;
constexpr size_t WS_MQ = WS_SV + 16 * MiB;
constexpr size_t WS_GATE = WS_MQ + 128 * MiB;
constexpr size_t WS_GLRP = WS_GATE + 384 * MiB;
constexpr size_t WS_KD = WS_GLRP + 8 * MiB;
constexpr size_t WS_PC = WS_KD + 64 * MiB;
constexpr size_t WS_GAM = WS_PC + 16 * MiB;
constexpr size_t WS_PM = WS_GAM + 2 * MiB;
constexpr size_t WS_VTM = WS_PM + 32 * MiB;
constexpr size_t WS_RQ = WS_VTM + 4 * MiB;
constexpr size_t WS_END = WS_RQ + 1 * MiB;
constexpr size_t WS_GA = WS_GV;
static_assert(WS_GA + (size_t)512 * MiB <= WS_GATE, "GA overlay");
static_assert(WS_END <= (size_t)2113 * MiB, "workspace");

constexpr int CW_TMO = 0, CW_BAR = 256;

constexpr int RING_BYTES = 131072;
constexpr int LDSCTL_OFF = RING_BYTES, MISC_OFF = LDSCTL_OFF + 320;
constexpr int LDS_BYTES = 147456;

#define RLX_AGENT __ATOMIC_RELAXED, __HIP_MEMORY_SCOPE_AGENT
#define LDS_WAIT() asm volatile("s_waitcnt lgkmcnt(0)" ::: "memory")
#define VM_WAIT() asm volatile("s_waitcnt vmcnt(0)" ::: "memory")
__device__ __forceinline__ unsigned f2bf(float f) { unsigned u = __builtin_bit_cast(unsigned, f); return (u + 0x7fffu + ((u >> 16) & 1u)) >> 16; }
__device__ __forceinline__ unsigned pk2(float lo, float hi) { return f2bf(lo) | (f2bf(hi) << 16); }
__device__ __forceinline__ float bf2f(unsigned b) { return __builtin_bit_cast(float, b << 16); }
__device__ __forceinline__ float bflo(unsigned w) { return __builtin_bit_cast(float, w << 16); }
__device__ __forceinline__ float bfhi(unsigned w) { return __builtin_bit_cast(float, w & 0xffff0000u); }
__device__ __forceinline__ unsigned cvt_pk_bf16(float lo, float hi) { unsigned r; asm volatile("v_cvt_pk_bf16_f32 %0, %1, %2" : "=v"(r) : "v"(lo), "v"(hi)); return r; }
__device__ __forceinline__ int lane_id() { return (int)__builtin_amdgcn_mbcnt_hi(~0u, __builtin_amdgcn_mbcnt_lo(~0u, 0u)); }
__device__ __forceinline__ int fresh_lane() { int l; asm volatile("v_mbcnt_lo_u32_b32 %0, -1, 0\n\tv_mbcnt_hi_u32_b32 %0, -1, %0" : "=v"(l)); return l; }
__device__ __forceinline__ float wave_sum(float v) {
#pragma unroll
    for (int o = 1; o < 64; o <<= 1) v += __shfl_xor(v, o);
    return v;
}
__device__ __forceinline__ float wave_max(float v) {
#pragma unroll
    for (int o = 1; o < 64; o <<= 1) v = fmaxf(v, __shfl_xor(v, o));
    return v;
}

#define XB_TMO      128
#define XB_XCNT(j)  (256  + 64 * (j))
#define XB_XSUB(j)  (1280 + 64 * (j))
#define XB_XGEN(j)  (2304 + 64 * (j))
#define XB_TOP      3328
#define XB_TOPGEN   3392
#define XCD_BAR_WORDS 3456
#define XB_SPIN_CAP (1u << 18)
__device__ __forceinline__ unsigned xb_ld(unsigned* p)              { return __hip_atomic_load(p, __ATOMIC_RELAXED, __HIP_MEMORY_SCOPE_AGENT); }
__device__ __forceinline__ unsigned xb_add(unsigned* p, unsigned v) { return __hip_atomic_fetch_add(p, v, __ATOMIC_RELAXED, __HIP_MEMORY_SCOPE_AGENT); }
__device__ __forceinline__ unsigned xb_xcc_id() { return (unsigned)__builtin_amdgcn_s_getreg((3 << 11) | 20) & 0xFu; }
#define XB_SPIN(cond, bar) do { unsigned _sp = 0; while (cond) { __builtin_amdgcn_s_sleep(1); \
    if ((++_sp & 255u) == 0u) { if (xb_ld(&(bar)[XB_TMO])) break; if (_sp > XB_SPIN_CAP) { atomicAdd(&(bar)[XB_TMO], 1u); break; } } } } while (0)
struct XcdBarrier { unsigned* bar; unsigned x; volatile LAS unsigned* st; };
__device__ __forceinline__ XcdBarrier xcd_barrier_post(unsigned* bar, volatile LAS unsigned* st) {
    XcdBarrier b; b.bar = bar; b.x = xb_xcc_id(); b.st = st;
    if (threadIdx.x == 0) (void)xb_add(&bar[XB_XCNT(b.x)], 1u);
    return b;
}
__device__ __forceinline__ void xcd_barrier_complete(unsigned* bar, unsigned x, unsigned& nloc, unsigned& nx) {
    const unsigned G = gridDim.x * gridDim.y * gridDim.z;
    unsigned sum, cnt, mine, sp = 0u;
    for (;;) {
        sum = 0u; cnt = 0u; mine = 0u;
#pragma unroll
        for (unsigned j = 0; j < 16; ++j) { const unsigned c = xb_ld(&bar[XB_XCNT(j)]); sum += c; cnt += (c > 0u) ? 1u : 0u; mine = (j == x) ? c : mine; }
        if (sum == G) break;
        __builtin_amdgcn_s_sleep(1);
        if ((++sp & 255u) == 0u) { if (xb_ld(&bar[XB_TMO])) break; if (sp > XB_SPIN_CAP) { atomicAdd(&bar[XB_TMO], 1u); break; } }
    }
    nloc = mine > 0u ? mine : 1u; nx = cnt > 0u ? cnt : 1u;
}
__device__ __forceinline__ void xcd_barrier(const XcdBarrier& b, int tid0) {
    asm volatile("s_waitcnt vmcnt(0)" ::: "memory");
    __syncthreads();
    if (tid0 == 0) {
        unsigned* bar = b.bar;
        __builtin_amdgcn_s_waitcnt(0);
        unsigned nloc = b.st[0], nx = b.st[1];
        if (nloc == 0u) { xcd_barrier_complete(bar, b.x, nloc, nx); b.st[0] = nloc; b.st[1] = nx; }
        const unsigned old = xb_add(&bar[XB_XSUB(b.x)], 1u);
        const unsigned gen = old / nloc;
        if (old + 1u == (gen + 1u) * nloc) {
            __builtin_amdgcn_fence(__ATOMIC_RELEASE, "agent");
            asm volatile("s_waitcnt vmcnt(0)" ::: "memory");
            const unsigned og = xb_add(&bar[XB_TOP], 1u);
            const unsigned tg = og / nx;
            if (og + 1u == (tg + 1u) * nx) xb_add(&bar[XB_TOPGEN], 1u);
            else XB_SPIN(xb_ld(&bar[XB_TOPGEN]) == tg, bar);
            __builtin_amdgcn_fence(__ATOMIC_ACQUIRE, "agent");
            xb_add(&bar[XB_XGEN(b.x)], 1u);
            asm volatile("s_waitcnt vmcnt(0)" ::: "memory");
        } else {
            XB_SPIN(xb_ld(&bar[XB_XGEN(b.x)]) == gen, bar);
            __builtin_amdgcn_fence(__ATOMIC_ACQUIRE, "agent");
            asm volatile("s_waitcnt vmcnt(0)" ::: "memory");
        }
    }
    __syncthreads();
}

namespace pg8 {
constexpr int BM = 256, BK = 64, HALF = 128, HTB = HALF * BK * 2, STAGE_BYTES = 8 * HTB, NXCD = 8, WGM = 8;
__host__ __device__ __forceinline__ int lds_byte(int r, int c) { const int st = (r >> 4) * 2 + (c >> 5), rr = r & 15, cc = c & 31, ob = rr * 64 + cc * 2; return st * 1024 + (ob ^ (((ob >> 9) & 1) << 5)); }
__host__ __device__ __forceinline__ void stage_rc(int b, int& R, int& C) { const int st = b / 1024, sb = b % 1024, swz = sb ^ (((sb >> 9) & 1) << 5); R = (st >> 1) * 16 + swz / 64; C = (st & 1) * 32 + (swz % 64) / 2; }
__host__ __device__ __forceinline__ int perm32(int rho) { const int n = rho >> 4, i = rho & 15; return 8 * (i >> 2) + 4 * n + (i & 3); }

struct GUnit { const char* A; const char* B; char* C; int ldc; int pm, pn, z; float scale; };
struct GemmG { int lda, ldb, K; };
__device__ __forceinline__ void tile_order(int L, int nM, int nN, int& pm, int& pn) {
    const int nwg = nM * nN; int wgid = L;
    { const int q = nwg / NXCD, r = nwg % NXCD, xcd = wgid % NXCD, off = wgid / NXCD; wgid = (xcd < r ? xcd * (q + 1) : r * (q + 1) + (xcd - r) * q) + off; }
    const int nig = WGM * nN, gid = wgid / nig, fm = gid * WGM, gsz = (nM - fm) < WGM ? (nM - fm) : WGM;
    pm = fm + ((wgid % nig) % gsz); pn = (wgid % nig) / gsz;
}

template <class Epi, class Sched>
__device__ __forceinline__ void gemm_phase(LAS uchar* lds, const GemmG g, const Sched& S, const Epi& E, int wave_s) {
    int tid_ = wave_s * 64 + lane_id(); asm volatile("" : "+v"(tid_));
    const int tid = tid_, wid = __builtin_amdgcn_readfirstlane(tid >> 6), lane = tid & 63, wr = wid >> 2, wc = wid & 3, fr = lane & 15, fq = lane >> 4;
    const int K = g.K, nt = K / BK;
    unsigned voffA[2], voffB[2];
#pragma unroll
    for (int i = 0; i < 2; ++i) { int R, C; stage_rc(tid * 16 + i * 8192, R, C); const int Rb = Epi::PERM ? ((R & ~31) + perm32(R & 31)) : R;
        voffA[i] = (unsigned)(R * g.lda + C) * 2u; voffB[i] = (unsigned)(Rb * g.ldb + C) * 2u; }
    const size_t kstep = (size_t)(BK * 2);
    const size_t hstepA = (size_t)HALF * g.lda * 2, hstepB = (size_t)HALF * g.ldb * 2;
    const unsigned ldsw = (unsigned)wid * 1024u;
    const int aoff = lds_byte(wr * 64 + fr, fq * 8), boff = lds_byte(wc * 32 + fr, fq * 8);
#define PG8_SA(b, h) (((b) * 2 + (h)) * HTB)
#define PG8_SB(b, h) ((4 + (b) * 2 + (h)) * HTB)
#define PG8_STAGE(bufoff, gbase, voff) do { _Pragma("unroll") for (int _i = 0; _i < 2; ++_i) \
        __builtin_amdgcn_global_load_lds((const unsigned*)((const char*)(gbase) + (voff)[_i]), (LAS unsigned*)(lds + (bufoff) + ldsw + _i * 8192), 16, 0, 0); } while (0)
#define PG8_LDA(dst, b, h) do { _Pragma("unroll") for (int m = 0; m < 4; ++m) _Pragma("unroll") for (int k = 0; k < 2; ++k) dst[m][k] = *(const LAS bf16x8*)(lds + PG8_SA(b, h) + aoff + m * 2048 + k * 1024); } while (0)
#define PG8_LDB(dst, b, h) do { _Pragma("unroll") for (int n = 0; n < 2; ++n) _Pragma("unroll") for (int k = 0; k < 2; ++k) dst[n][k] = *(const LAS bf16x8*)(lds + PG8_SB(b, h) + boff + n * 2048 + k * 1024); } while (0)
#define PG8_MMA(ai, bj, At, Bt) do { __builtin_amdgcn_s_setprio(1); _Pragma("unroll") for (int m = 0; m < 4; ++m) _Pragma("unroll") for (int n = 0; n < 2; ++n) _Pragma("unroll") for (int k = 0; k < 2; ++k) \
        acc[ai][bj][m][n] = __builtin_amdgcn_mfma_f32_16x16x32_bf16(Bt[n][k], At[m][k], acc[ai][bj][m][n], 0, 0, 0); __builtin_amdgcn_s_setprio(0); } while (0)
#define PG8_WAIT_V(n) asm volatile("s_waitcnt vmcnt(" #n ")" ::: "memory")
#define PG8_WAIT_L(n) asm volatile("s_waitcnt lgkmcnt(" #n ")" ::: "memory")
#define PG8_BAR __builtin_amdgcn_s_barrier()
#define PG8_SCHED __builtin_amdgcn_sched_barrier(0)
    GUnit cur, nxt; int ui = 0;
    if (!S.next(0, cur)) return;
    f32x4 acc[2][2][4][2];
#pragma unroll
    for (int a = 0; a < 2; ++a)
#pragma unroll
        for (int b = 0; b < 2; ++b)
#pragma unroll
            for (int m = 0; m < 4; ++m)
#pragma unroll
                for (int n = 0; n < 2; ++n) acc[a][b][m][n] = (f32x4){0.f, 0.f, 0.f, 0.f};
    bf16x8 At[4][2], B0[2][2], B1[2][2];
    const char* cA = cur.A; const char* cB = cur.B;
    PG8_STAGE(PG8_SB(0, 0), cB, voffB); PG8_STAGE(PG8_SB(0, 1), cB + hstepB, voffB); PG8_STAGE(PG8_SA(0, 0), cA, voffA); PG8_STAGE(PG8_SA(0, 1), cA + hstepA, voffA);
    if (wr == 1) PG8_BAR;
    PG8_WAIT_V(2); PG8_BAR;
    PG8_STAGE(PG8_SB(1, 0), cB + kstep, voffB); PG8_STAGE(PG8_SA(1, 0), cA + kstep, voffA); PG8_STAGE(PG8_SB(1, 1), cB + hstepB + kstep, voffB);
    PG8_WAIT_V(6); PG8_BAR;
    for (;;) {
        const bool has_next = S.next(ui + 1, nxt);
        const char* nA = has_next ? nxt.A : cA; const char* nB = has_next ? nxt.B : cB;
        for (int t = 0; t < nt; t += 2) {
            const bool last = (t == nt - 2);
            const char* a1 = cA + (size_t)(t + 1) * kstep;
            const char* a2 = last ? nA : cA + (size_t)(t + 2) * kstep; const char* b2 = last ? nB : cB + (size_t)(t + 2) * kstep;
            const char* a3 = a2 + kstep; const char* b3 = b2 + kstep;
            PG8_LDB(B0, 0, 0); PG8_LDB(B1, 0, 1); PG8_SCHED; PG8_LDA(At, 0, 0); PG8_STAGE(PG8_SA(1, 1), a1 + hstepA, voffA);
            PG8_WAIT_V(8); PG8_WAIT_L(0); PG8_BAR; PG8_MMA(0, 0, At, B0); PG8_MMA(0, 1, At, B1); PG8_BAR; PG8_SCHED;
            PG8_LDA(At, 0, 1); PG8_STAGE(PG8_SB(0, 0), b2, voffB); PG8_STAGE(PG8_SB(0, 1), b2 + hstepB, voffB); PG8_STAGE(PG8_SA(0, 0), a2, voffA);
            PG8_WAIT_V(8); PG8_WAIT_L(0); PG8_BAR; PG8_MMA(1, 0, At, B0); PG8_MMA(1, 1, At, B1); PG8_BAR; PG8_SCHED;
            PG8_LDB(B0, 1, 0); PG8_LDB(B1, 1, 1); PG8_SCHED; PG8_LDA(At, 1, 0); PG8_STAGE(PG8_SA(0, 1), a2 + hstepA, voffA);
            PG8_WAIT_V(8); PG8_WAIT_L(0); PG8_BAR; PG8_MMA(0, 0, At, B0); PG8_MMA(0, 1, At, B1); PG8_BAR; PG8_SCHED;
            PG8_LDA(At, 1, 1); PG8_STAGE(PG8_SB(1, 0), b3, voffB); PG8_STAGE(PG8_SB(1, 1), b3 + hstepB, voffB); PG8_STAGE(PG8_SA(1, 0), a3, voffA);
            PG8_WAIT_V(8); PG8_WAIT_L(0); PG8_BAR; PG8_MMA(1, 0, At, B0); PG8_MMA(1, 1, At, B1); PG8_BAR; PG8_SCHED;
        }
        if (wr == 0) PG8_BAR;
        E(acc, cur, wr, wc, fr, fq);
        if (!has_next) break;
#pragma unroll
        for (int a = 0; a < 2; ++a)
#pragma unroll
            for (int b = 0; b < 2; ++b)
#pragma unroll
                for (int m = 0; m < 4; ++m)
#pragma unroll
                    for (int n = 0; n < 2; ++n) acc[a][b][m][n] = (f32x4){0.f, 0.f, 0.f, 0.f};
        cur = nxt; cA = nA; cB = nB; ++ui;
        if (wr == 1) PG8_BAR;
    }
    PG8_WAIT_V(0);
    PG8_BAR;
#undef PG8_SA
#undef PG8_SB
#undef PG8_STAGE
#undef PG8_LDA
#undef PG8_LDB
#undef PG8_MMA
#undef PG8_WAIT_V
#undef PG8_WAIT_L
#undef PG8_BAR
#undef PG8_SCHED
}

struct EpiBf16 {
    static constexpr bool PERM = true;
    __device__ __forceinline__ void operator()(const f32x4 (&acc)[2][2][4][2], const GUnit& u, int wr, int wc, int fr, int fq) const {
        const int l_ = fresh_lane(); fr = l_ & 15; fq = l_ >> 4;
        bf16* base = (bf16*)u.C + (size_t)(wr * 64 + fr) * u.ldc + wc * 32 + 8 * fq; const float s = u.scale;
#pragma unroll
        for (int ai = 0; ai < 2; ++ai)
#pragma unroll
            for (int m = 0; m < 4; ++m) { bf16* rowp = base + (size_t)(ai * HALF + m * 16) * u.ldc;
#pragma unroll
                for (int bj = 0; bj < 2; ++bj) { const f32x4 v0 = acc[ai][bj][m][0] * s, v1 = acc[ai][bj][m][1] * s;
                    v4u w; w.x = cvt_pk_bf16(v0[0], v0[1]); w.y = cvt_pk_bf16(v0[2], v0[3]); w.z = cvt_pk_bf16(v1[0], v1[1]); w.w = cvt_pk_bf16(v1[2], v1[3]);
                    *(v4u*)(rowp + bj * HALF) = w; } }
    }
};
struct EpiF32 {
    static constexpr bool PERM = false;
    const float* R;
    __device__ __forceinline__ void operator()(const f32x4 (&acc)[2][2][4][2], const GUnit& u, int wr, int wc, int fr, int fq) const {
        float* base = (float*)u.C + (size_t)(wr * 64 + fr) * u.ldc + wc * 32 + 4 * fq;
        const float* rb = R ? R + ((size_t)u.pm * BM + wr * 64 + fr) * u.ldc + (size_t)u.pn * BM + wc * 32 + 4 * fq : nullptr;
#pragma unroll
        for (int ai = 0; ai < 2; ++ai)
#pragma unroll
            for (int m = 0; m < 4; ++m) { const size_t ro = (size_t)(ai * HALF + m * 16) * u.ldc;
#pragma unroll
                for (int bj = 0; bj < 2; ++bj)
#pragma unroll
                    for (int n = 0; n < 2; ++n) { f32x4 v = acc[ai][bj][m][n]; if (rb) v += *(const f32x4*)(rb + ro + bj * HALF + n * 16); *(f32x4*)(base + ro + bj * HALF + n * 16) = v; } }
    }
};
struct EpiMerge {
    static constexpr bool PERM = true;
    const bf16* gate; float* mixf; bf16* mixb;
    __device__ __forceinline__ void operator()(const f32x4 (&acc)[2][2][4][2], const GUnit& u, int wr, int wc, int fr, int fq) const {
        const size_t row0 = (size_t)u.pm * BM + wr * 64 + fr; const int col0 = u.pn * BM + wc * 32 + 8 * fq;
#pragma unroll
        for (int ai = 0; ai < 2; ++ai)
#pragma unroll
            for (int m = 0; m < 4; ++m) { const size_t row = row0 + ai * HALF + m * 16;
#pragma unroll
                for (int bj = 0; bj < 2; ++bj) { const int col = col0 + bj * HALF;
                    const v4u gw = *(const v4u*)(gate + row * 12288 + (size_t)u.z * 4096 + col);
                    float gl[8] = {bflo(gw.x), bfhi(gw.x), bflo(gw.y), bfhi(gw.y), bflo(gw.z), bfhi(gw.z), bflo(gw.w), bfhi(gw.w)};
                    f32x4 v0 = acc[ai][bj][m][0], v1 = acc[ai][bj][m][1];
#pragma unroll
                    for (int j = 0; j < 4; ++j) { v0[j] *= 1.0f / (1.0f + __expf(-gl[j])); v1[j] *= 1.0f / (1.0f + __expf(-gl[4 + j])); }
                    float* mp = mixf + row * 4096 + col;
                    if (u.z != 0) { v0 += *(const f32x4*)mp; v1 += *(const f32x4*)(mp + 4); }
                    if (u.z != 2) { *(f32x4*)mp = v0; *(f32x4*)(mp + 4) = v1; }
                    else { v4u w; w.x = cvt_pk_bf16(v0[0], v0[1]); w.y = cvt_pk_bf16(v0[2], v0[3]); w.z = cvt_pk_bf16(v1[0], v1[1]); w.w = cvt_pk_bf16(v1[2], v1[3]);
                        *(v4u*)(mixb + row * 4096 + col) = w; } } }
    }
};

__device__ __forceinline__ f32x2 gelu_pk(f32x2 v) {
    const f32x2 av = __builtin_elementwise_abs(v), d = av * 0.2316418882f + 1.0f;
    f32x2 t; t.x = __builtin_amdgcn_rcpf(d.x); t.y = __builtin_amdgcn_rcpf(d.y);
    f32x2 q = t * 0.5307027145f + (-0.7265760135f); q = q * t + 0.7107068705f; q = q * t + (-0.142248368f); q = q * t + 0.127414796f; q = q * t;
    const f32x2 s = (v * v) * (-0.72134752044f);
    f32x2 e; e.x = __builtin_amdgcn_exp2f(s.x); e.y = __builtin_amdgcn_exp2f(s.y);
    const f32x2 m = v * (q * e), r = v - m;
    f32x2 o; o.x = v.x < 0.f ? m.x : r.x; o.y = v.y < 0.f ? m.y : r.y; return o;
}
struct EpiPeerA {
    static constexpr bool PERM = true;
    bf16* ga;
    __device__ __forceinline__ void operator()(const f32x4 (&acc)[2][2][4][2], const GUnit& u, int wr, int wc, int fr, int fq) const {
        const size_t row0 = (size_t)u.pm * BM + wr * 64 + fr; const int col0 = u.pn * BM + wc * 32 + 8 * fq;
#pragma unroll
        for (int ai = 0; ai < 2; ++ai)
#pragma unroll
            for (int m = 0; m < 4; ++m) { const size_t row = row0 + ai * HALF + m * 16;
#pragma unroll
                for (int bj = 0; bj < 2; ++bj) { bf16* p = ga + row * 16384 + col0 + bj * HALF;
                    const v4u gw = *(const v4u*)p;
                    if ((gw.x | gw.y | gw.z | gw.w) != 0u) {
                        const f32x4 v0 = acc[ai][bj][m][0], v1 = acc[ai][bj][m][1];
                        const f32x2 a = gelu_pk((f32x2){v0[0], v0[1]}), b = gelu_pk((f32x2){v0[2], v0[3]}), c = gelu_pk((f32x2){v1[0], v1[1]}), d = gelu_pk((f32x2){v1[2], v1[3]});
                        v4u w; w.x = cvt_pk_bf16(a.x * bflo(gw.x), a.y * bfhi(gw.x)); w.y = cvt_pk_bf16(b.x * bflo(gw.y), b.y * bfhi(gw.y));
                        w.z = cvt_pk_bf16(c.x * bflo(gw.z), c.y * bfhi(gw.z)); w.w = cvt_pk_bf16(d.x * bflo(gw.w), d.y * bfhi(gw.w));
                        *(v4u*)p = w; } } }
    }
};
}

struct Ptrs {
    const float* in[23]; float* out; uchar* ws;
};
struct SchedP1 {
    uchar* ws; int G, c;
    __device__ __forceinline__ bool next(int i, pg8::GUnit& u) const {
        const int L = i * G + c; constexpr int NREG = 64 * 133;
        if (L >= NREG + 64) return false;
        u.scale = 1.f; u.z = 0;
        if (L < NREG) {
            int pm, pn; pg8::tile_order(L, 64, 133, pm, pn); u.pm = pm; u.pn = pn;
            u.A = (const char*)(ws + WS_XN) + (size_t)pm * 256 * D * 2; u.B = (const char*)(ws + WS_WIN_T) + (size_t)pn * 256 * D * 2;
            size_t base; int ldc, ct;
            if (pn < 8) { base = WS_GQ; ldc = 2048; ct = pn; u.scale = 0.0625f; }
            else if (pn < 16) { base = WS_GK; ldc = 2048; ct = pn - 8; }
            else if (pn < 32) { base = WS_GV; ldc = 4096; ct = pn - 16; }
            else if (pn < 48) { base = WS_GR; ldc = 4096; ct = pn - 32; }
            else if (pn < 64) { base = WS_SQ; ldc = 4096; ct = pn - 48; }
            else if (pn < 66) { base = WS_SK; ldc = 512; ct = pn - 64; }
            else if (pn < 68) { base = WS_SV; ldc = 512; ct = pn - 66; }
            else if (pn < 84) { base = WS_MQ; ldc = 4096; ct = pn - 68; }
            else if (pn < 132) { base = WS_GATE; ldc = 12288; ct = pn - 84; }
            else { base = WS_GLRP; ldc = 256; ct = 0; }
            u.ldc = ldc; u.C = (char*)(ws + base) + ((size_t)pm * 256 * ldc + (size_t)ct * 256) * 2;
        } else {
            const int j = L - NREG, pm = j >> 5, pn = j & 31; u.pm = pm; u.pn = pn; u.z = 1;
            u.A = (const char*)(ws + WS_MEMN) + (size_t)pm * 256 * D * 2; u.B = (const char*)(ws + WS_WKV_T) + (size_t)pn * 256 * D * 2;
            u.ldc = 8192; u.C = (char*)(ws + WS_KVM) + ((size_t)pm * 256 * 8192 + (size_t)pn * 256) * 2;
        }
        return true;
    }
};
struct SchedMerge {
    uchar* ws; int G, c;
    __device__ __forceinline__ bool next(int i, pg8::GUnit& u) const {
        const int r = i / 3, z = i - 3 * r, L = r * G + c;
        if (L >= 64 * 16) return false;
        int pm, pn; pg8::tile_order(L, 64, 16, pm, pn); u.pm = pm; u.pn = pn; u.z = z; u.scale = 1.f; u.ldc = 4096; u.C = nullptr;
        const size_t ab = z == 0 ? WS_GV : (z == 1 ? WS_SQ : WS_MQ);
        u.A = (const char*)(ws + ab) + (size_t)pm * 256 * D * 2; u.B = (const char*)(ws + WS_WBR_T) + ((size_t)z * 4096 + (size_t)pn * 256) * D * 2;
        return true;
    }
};
struct SchedPlain {
    const char* A; const char* B; char* C; int nM, nN, K, esz, G, c;
    __device__ __forceinline__ bool next(int i, pg8::GUnit& u) const {
        const int L = i * G + c; if (L >= nM * nN) return false;
        int pm, pn; pg8::tile_order(L, nM, nN, pm, pn); u.pm = pm; u.pn = pn; u.z = 0; u.scale = 1.f; u.ldc = nN * 256;
        u.A = A + (size_t)pm * 256 * K * 2; u.B = B + (size_t)pn * 256 * K * 2; u.C = C + ((size_t)pm * 256 * u.ldc + (size_t)pn * 256) * esz;
        return true;
    }
};

struct SchedMemS {
    uchar* ws; int G, c;
    __device__ __forceinline__ bool next(int i, pg8::GUnit& u) const {
        const int L = i * G + c; if (L >= 256) return false;
        const int pm = L >> 2, h = L & 3, b = pm >> 5; u.pm = pm; u.pn = 0; u.z = h; u.scale = 1.f; u.ldc = 0; u.C = nullptr;
        u.A = (const char*)(ws + WS_MQ) + ((size_t)pm * 256 * 4096 + (size_t)h * 1024) * 2; u.B = (const char*)(ws + WS_KVM) + ((size_t)b * 256 * 8192 + (size_t)h * 1024) * 2;
        return true;
    }
};
struct SchedMemO {
    uchar* ws; int G, c;
    __device__ __forceinline__ bool next(int i, pg8::GUnit& u) const {
        const int L = i * G + c; if (L >= 1024) return false;
        const int pm = L >> 4, h = (L >> 2) & 3, pn = L & 3, b = pm >> 5; u.pm = pm; u.pn = pn; u.z = h; u.scale = 1.f; u.ldc = 4096;
        u.A = (const char*)(ws + WS_PM) + ((size_t)pm * 256 * 1024 + (size_t)h * 256) * 2; u.B = (const char*)(ws + WS_VTM) + ((size_t)(b * 4096 + h * 1024 + pn * 256) * 256) * 2;
        u.C = (char*)(ws + WS_MQ) + ((size_t)pm * 256 * 4096 + (size_t)h * 1024 + (size_t)pn * 256) * 2;
        return true;
    }
};
namespace pg8 {
struct EpiMemS {
    static constexpr bool PERM = true;
    const float* rq; bf16* pmat; LAS float* part;
    __device__ __forceinline__ void operator()(f32x4 (&acc)[2][2][4][2], const GUnit& u, int wr, int wc, int fr, int fq) const {
        const int h = u.z;
#pragma unroll
        for (int ai = 0; ai < 2; ++ai)
#pragma unroll
            for (int m = 0; m < 4; ++m) { const int row = ai * HALF + wr * 64 + m * 16 + fr; const float sc = rq[((size_t)u.pm * BM + row) * 4 + h] * 1.44269504f; float s = 0.f;
#pragma unroll
                for (int bj = 0; bj < 2; ++bj)
#pragma unroll
                    for (int n = 0; n < 2; ++n) { f32x4 v = acc[ai][bj][m][n] * sc;
#pragma unroll
                        for (int j = 0; j < 4; ++j) { v[j] = __builtin_amdgcn_exp2f(v[j]); s += v[j]; }
                        acc[ai][bj][m][n] = v; }
                s += __shfl_xor(s, 16); s += __shfl_xor(s, 32);
                if (fq == 0) part[row * 4 + wc] = s; }
        asm volatile("s_waitcnt lgkmcnt(0)" ::: "memory"); __builtin_amdgcn_s_barrier(); asm volatile("" ::: "memory");
#pragma unroll
        for (int ai = 0; ai < 2; ++ai)
#pragma unroll
            for (int m = 0; m < 4; ++m) { int row = ai * HALF + wr * 64 + m * 16 + fr; asm volatile("" : "+v"(row)); const f32x4 pp = *(const LAS f32x4*)(part + row * 4); const float inv = 1.0f / ((pp.x + pp.y) + (pp.z + pp.w));
                bf16* rowp = pmat + ((size_t)u.pm * BM + row) * 1024 + h * 256 + wc * 32 + 8 * fq;
#pragma unroll
                for (int bj = 0; bj < 2; ++bj) { const f32x4 v0 = acc[ai][bj][m][0] * inv, v1 = acc[ai][bj][m][1] * inv;
                    v4u w; w.x = cvt_pk_bf16(v0[0], v0[1]); w.y = cvt_pk_bf16(v0[2], v0[3]); w.z = cvt_pk_bf16(v1[0], v1[1]); w.w = cvt_pk_bf16(v1[2], v1[3]);
                    *(v4u*)(rowp + bj * HALF) = w; } }
        asm volatile("s_waitcnt lgkmcnt(0)" ::: "memory"); __builtin_amdgcn_s_barrier(); asm volatile("" ::: "memory");
    }
};
}

constexpr int SWA_KP = 144, SWA_VP = 528;
constexpr int SWA_KOFF = 0, SWA_VOFF = 256 * SWA_KP;
__device__ __forceinline__ void swa_unit(LAS uchar* lds, bf16* sq, const bf16* sk, const bf16* sv, const float* gq, const float* gk, const float* sinks, int b, int blk, int kvh, int tid) {
    const int lane = tid & 63, wave = __builtin_amdgcn_readfirstlane(tid >> 6);
    const long tq0 = (long)b * SEQ + (long)blk * 128, tk0 = tq0 - 128;
#pragma unroll
    for (int r = 0; r < 4; ++r) {
        const int idx = tid + 512 * r, key = idx >> 3, ch = idx & 7;
        v4u kw = {0u, 0u, 0u, 0u}, vw = {0u, 0u, 0u, 0u};
        if (blk > 0 || key >= 128) { kw = *(const GAS v4u*)(sk + (tk0 + key) * 512 + kvh * 64 + ch * 8); vw = *(const GAS v4u*)(sv + (tk0 + key) * 512 + kvh * 64 + ch * 8); }
        float kf[8] = {bflo(kw.x), bfhi(kw.x), bflo(kw.y), bfhi(kw.y), bflo(kw.z), bfhi(kw.z), bflo(kw.w), bfhi(kw.w)};
        float ss = 0.f;
#pragma unroll
        for (int i = 0; i < 8; ++i) ss += kf[i] * kf[i];
        ss += __shfl_xor(ss, 1); ss += __shfl_xor(ss, 2); ss += __shfl_xor(ss, 4);
        const float rr = rsqrtf(ss * (1.f / 64.f) + EPS);
        const f32x4 g0 = *(const GAS f32x4*)(gk + ch * 8), g1 = *(const GAS f32x4*)(gk + ch * 8 + 4);
        v4u o; o.x = pk2(kf[0] * rr * g0.x, kf[1] * rr * g0.y); o.y = pk2(kf[2] * rr * g0.z, kf[3] * rr * g0.w); o.z = pk2(kf[4] * rr * g1.x, kf[5] * rr * g1.y); o.w = pk2(kf[6] * rr * g1.z, kf[7] * rr * g1.w);
        *(LAS v4u*)(lds + SWA_KOFF + key * SWA_KP + ch * 16) = o;
        const unsigned vv[4] = {vw.x, vw.y, vw.z, vw.w};
#pragma unroll
        for (int i = 0; i < 4; ++i) { *(LAS unsigned short*)(lds + SWA_VOFF + (ch * 8 + 2 * i) * SWA_VP + key * 2) = (unsigned short)(vv[i] & 0xffffu);
                                      *(LAS unsigned short*)(lds + SWA_VOFF + (ch * 8 + 2 * i + 1) * SWA_VP + key * 2) = (unsigned short)(vv[i] >> 16); }
    }
    LDS_WAIT(); __syncthreads();
    const int g = wave, hq = kvh * 8 + g, r16 = lane & 15, g4 = lane >> 4;
    const float sink = sinks[hq];
    const f32x4 gqa = *(const GAS f32x4*)(gq + 8 * g4), gqb = *(const GAS f32x4*)(gq + 8 * g4 + 4), gqc = *(const GAS f32x4*)(gq + 32 + 8 * g4), gqd = *(const GAS f32x4*)(gq + 32 + 8 * g4 + 4);
    for (int ti = 0; ti < 8; ++ti) {
        bf16* qp = sq + (tq0 + 16 * ti + r16) * 4096 + hq * 64;
        const v4u q0 = *(const GAS v4u*)(qp + 8 * g4), q1 = *(const GAS v4u*)(qp + 32 + 8 * g4);
        float qa[8] = {bflo(q0.x), bfhi(q0.x), bflo(q0.y), bfhi(q0.y), bflo(q0.z), bfhi(q0.z), bflo(q0.w), bfhi(q0.w)};
        float qb[8] = {bflo(q1.x), bfhi(q1.x), bflo(q1.y), bfhi(q1.y), bflo(q1.z), bfhi(q1.z), bflo(q1.w), bfhi(q1.w)};
        float ss = 0.f;
#pragma unroll
        for (int i = 0; i < 8; ++i) ss += qa[i] * qa[i] + qb[i] * qb[i];
        ss += __shfl_xor(ss, 16); ss += __shfl_xor(ss, 32);
        const float rq = rsqrtf(ss * (1.f / 64.f) + EPS) * 0.125f;
        v4u qw0, qw1;
        qw0.x = pk2(qa[0] * rq * gqa.x, qa[1] * rq * gqa.y); qw0.y = pk2(qa[2] * rq * gqa.z, qa[3] * rq * gqa.w); qw0.z = pk2(qa[4] * rq * gqb.x, qa[5] * rq * gqb.y); qw0.w = pk2(qa[6] * rq * gqb.z, qa[7] * rq * gqb.w);
        qw1.x = pk2(qb[0] * rq * gqc.x, qb[1] * rq * gqc.y); qw1.y = pk2(qb[2] * rq * gqc.z, qb[3] * rq * gqc.w); qw1.z = pk2(qb[4] * rq * gqd.x, qb[5] * rq * gqd.y); qw1.w = pk2(qb[6] * rq * gqd.z, qb[7] * rq * gqd.w);
        const bf16x8 qf0 = __builtin_bit_cast(bf16x8, qw0), qf1 = __builtin_bit_cast(bf16x8, qw1);
        f32x4 st[9];
#pragma unroll
        for (int c = 0; c < 9; ++c) {
            const LAS uchar* kp = lds + SWA_KOFF + (16 * (ti + c) + r16) * SWA_KP + 16 * g4;
            const bf16x8 k0 = *(const LAS bf16x8*)kp, k1 = *(const LAS bf16x8*)(kp + 64);
            f32x4 a = {0.f, 0.f, 0.f, 0.f};
            a = __builtin_amdgcn_mfma_f32_16x16x32_bf16(k0, qf0, a, 0, 0, 0);
            a = __builtin_amdgcn_mfma_f32_16x16x32_bf16(k1, qf1, a, 0, 0, 0);
            st[c] = a;
        }
        float mx = -INFINITY;
#pragma unroll
        for (int c = 0; c < 9; ++c)
#pragma unroll
            for (int i = 0; i < 4; ++i) { const int dlt = 16 * c + 4 * g4 + i - r16; const bool ok = (dlt >= 1) && (dlt <= 128) && (blk > 0 || (16 * (ti + c) + 4 * g4 + i) >= 128);
                st[c][i] = ok ? st[c][i] : -INFINITY; mx = fmaxf(mx, st[c][i]); }
        mx = fmaxf(mx, __shfl_xor(mx, 16)); mx = fmaxf(mx, __shfl_xor(mx, 32)); mx = fmaxf(mx, sink);
        float sum = 0.f;
#pragma unroll
        for (int c = 0; c < 9; ++c)
#pragma unroll
            for (int i = 0; i < 4; ++i) { const float p = __expf(st[c][i] - mx); st[c][i] = p; sum += p; }
        sum += __shfl_xor(sum, 16); sum += __shfl_xor(sum, 32);
        const float inv = 1.0f / (sum + __expf(sink - mx));
        f32x4 ot[4];
#pragma unroll
        for (int dt = 0; dt < 4; ++dt) ot[dt] = (f32x4){0.f, 0.f, 0.f, 0.f};
#pragma unroll
        for (int kk = 0; kk < 5; ++kk) {
            v4u pw; pw.x = pk2(st[2 * kk][0] * inv, st[2 * kk][1] * inv); pw.y = pk2(st[2 * kk][2] * inv, st[2 * kk][3] * inv);
            if (kk < 4) { pw.z = pk2(st[2 * kk + 1][0] * inv, st[2 * kk + 1][1] * inv); pw.w = pk2(st[2 * kk + 1][2] * inv, st[2 * kk + 1][3] * inv); } else { pw.z = 0u; pw.w = 0u; }
            const bf16x8 pf = __builtin_bit_cast(bf16x8, pw);
            const int t0 = ti + 2 * kk, t1 = (ti + 2 * kk + 1) > 15 ? 15 : (ti + 2 * kk + 1);
#pragma unroll
            for (int dt = 0; dt < 4; ++dt) {
                const LAS uchar* vp = lds + SWA_VOFF + (16 * dt + r16) * SWA_VP + 8 * g4;
                const v2u va = *(const LAS v2u*)(vp + 32 * t0), vb = *(const LAS v2u*)(vp + 32 * t1);
                v4u vw; vw.x = va.x; vw.y = va.y; vw.z = vb.x; vw.w = vb.y;
                ot[dt] = __builtin_amdgcn_mfma_f32_16x16x32_bf16(__builtin_bit_cast(bf16x8, vw), pf, ot[dt], 0, 0, 0);
            }
        }
#pragma unroll
        for (int dt = 0; dt < 4; ++dt) { v2u w; w.x = pk2(ot[dt][0], ot[dt][1]); w.y = pk2(ot[dt][2], ot[dt][3]); *(GAS v2u*)(qp + 16 * dt + 4 * g4) = w; }
    }
    __syncthreads();
}

__device__ __forceinline__ void gla_prep_item(LAS uchar* lds, uchar* ws, const float* wup, const float* bias, int it, int tid) {
    const int h = it & 7; const long t0 = (long)(it >> 3) * 64;
    const int d = tid & 255, half = tid >> 8, lane = tid & 63, wave = __builtin_amdgcn_readfirstlane(tid >> 6), r16 = lane & 15, g4 = lane >> 4;
    LAS float* glr_s = (LAS float*)lds; LAS float* tot_s = (LAS float*)(lds + 4096); LAS float* bl_s = (LAS float*)(lds + 5120);
    LAS uchar* Qs = lds + 8192; LAS uchar* Ks = Qs + 33792; LAS uchar* Kd = Ks + 33792;
    bf16* gq = (bf16*)(ws + WS_GQ); const bf16* gk = (const bf16*)(ws + WS_GK); const bf16* glrp = (const bf16*)(ws + WS_GLRP);
#pragma unroll
    for (int r = 0; r < 2; ++r) { const int idx = tid + 512 * r; glr_s[idx] = bf2f(glrp[(t0 + (idx >> 4)) * 256 + (idx & 15)]); }
    float wu[16];
#pragma unroll
    for (int r = 0; r < 16; ++r) wu[r] = wup[r * 2048 + h * 256 + d];
    const float bs = bias[h * 256 + d];
    LDS_WAIT(); __syncthreads();
    float bc[32]; float run = 0.f;
#pragma unroll
    for (int ii = 0; ii < 32; ++ii) { const int i = 32 * half + ii; float s = bs;
#pragma unroll
        for (int r4 = 0; r4 < 4; ++r4) { const f32x4 gv = *(const LAS f32x4*)(glr_s + i * 16 + 4 * r4); s += gv.x * wu[4 * r4] + gv.y * wu[4 * r4 + 1] + gv.z * wu[4 * r4 + 2] + gv.w * wu[4 * r4 + 3]; }
        const float ls = (fminf(s, 0.f) - log1pf(__expf(-fabsf(s)))) * 0.0625f; run += ls; bc[ii] = run; }
    if (half == 0) tot_s[d] = run;
    LDS_WAIT(); __syncthreads();
    const float off = half ? tot_s[d] : 0.f;
    if (half == 1) bl_s[d] = run + off;
    LDS_WAIT(); __syncthreads();
    const float bl = bl_s[d];
#pragma unroll 8
    for (int ii = 0; ii < 32; ++ii) { const int i = 32 * half + ii; const float b = bc[ii] + off; const float E = __expf(b), Ei = __expf(-b), Ed = __expf(bl - b);
        const size_t go = (size_t)(t0 + i) * 2048 + h * 256 + d; const float q = bf2f(gq[go]), k = bf2f(gk[go]);
        const unsigned short qt = (unsigned short)f2bf(q * E);
        *(LAS unsigned short*)(Qs + i * 528 + d * 2) = qt; *(LAS unsigned short*)(Ks + i * 528 + d * 2) = (unsigned short)f2bf(k * Ei); *(LAS unsigned short*)(Kd + d * 144 + i * 2) = (unsigned short)f2bf(k * Ed);
        gq[go] = qt; }
    if (half == 0) ((float*)(ws + WS_GAM))[(size_t)it * 256 + d] = __expf(bl);
    LDS_WAIT(); __syncthreads();
#pragma unroll
    for (int r = 0; r < 4; ++r) { const int idx = tid + 512 * r, dd = idx >> 3, ch = idx & 7; *(GAS v4u*)((bf16*)(ws + WS_KD) + ((size_t)it * 256 + dd) * 64 + ch * 8) = *(const LAS v4u*)(Kd + dd * 144 + ch * 16); }
    const int ti = wave >> 1;
#pragma unroll
    for (int tjj = 0; tjj < 2; ++tjj) { const int tj = 2 * (wave & 1) + tjj; f32x4 acc = {0.f, 0.f, 0.f, 0.f};
        if (tj <= ti) {
#pragma unroll
            for (int ks = 0; ks < 8; ++ks) { const bf16x8 a = *(const LAS bf16x8*)(Qs + (16 * ti + r16) * 528 + (32 * ks + 8 * g4) * 2), bb = *(const LAS bf16x8*)(Ks + (16 * tj + r16) * 528 + (32 * ks + 8 * g4) * 2);
                acc = __builtin_amdgcn_mfma_f32_16x16x32_bf16(a, bb, acc, 0, 0, 0); } }
#pragma unroll
        for (int ii = 0; ii < 4; ++ii) { const int i = 16 * ti + 4 * g4 + ii, j = 16 * tj + r16; ((bf16*)(ws + WS_PC))[(size_t)it * 4096 + i * 64 + j] = (unsigned short)f2bf(j <= i ? acc[ii] : 0.f); } }
    __syncthreads();
}
__device__ __forceinline__ void gla_scan_unit(LAS uchar* lds, uchar* ws, int u, int tid) {
    const int bh = u >> 4, sl = u & 15, b = bh >> 3, h = bh & 7;
    const int lane = tid & 63, wave = __builtin_amdgcn_readfirstlane(tid >> 6), r16 = lane & 15, g4 = lane >> 4, ti = wave >> 1, te = wave & 1;
    LAS uchar* Sb = lds; LAS uchar* VT = lds + 2 * 16896;
    const bf16* gq = (const bf16*)(ws + WS_GQ); bf16* gv = (bf16*)(ws + WS_GV); const bf16* pc = (const bf16*)(ws + WS_PC); const bf16* kd = (const bf16*)(ws + WS_KD); const float* gam = (const float*)(ws + WS_GAM);
    for (int i = tid; i < 16896 / 16; i += NTHR) *(LAS v4u*)(Sb + i * 16) = (v4u){0u, 0u, 0u, 0u};
    const int vj = tid >> 2, vec = tid & 3;
    f32x4 accS[2][2];
#pragma unroll
    for (int a = 0; a < 2; ++a)
#pragma unroll
        for (int c2 = 0; c2 < 2; ++c2) accS[a][c2] = (f32x4){0.f, 0.f, 0.f, 0.f};
    bf16x8 nq[8], np[2], nk[2][2]; f32x4 ng[2]; v4u nv = {0u, 0u, 0u, 0u};
#define GLA_LOAD(c) do { const long it_ = ((long)b * 128 + (c)) * 8 + h; const long t0_ = ((long)b * 128 + (c)) * 64; \
        _Pragma("unroll") for (int ks = 0; ks < 8; ++ks) nq[ks] = *(const GAS bf16x8*)(gq + (t0_ + 16 * ti + r16) * 2048 + h * 256 + 32 * ks + 8 * g4); \
        _Pragma("unroll") for (int ks = 0; ks < 2; ++ks) np[ks] = *(const GAS bf16x8*)(pc + it_ * 4096 + (16 * ti + r16) * 64 + 32 * ks + 8 * g4); \
        _Pragma("unroll") for (int tdd = 0; tdd < 2; ++tdd) { _Pragma("unroll") for (int ks = 0; ks < 2; ++ks) nk[tdd][ks] = *(const GAS bf16x8*)(kd + (it_ * 256 + 16 * (2 * wave + tdd) + r16) * 64 + 32 * ks + 8 * g4); \
            ng[tdd] = *(const GAS f32x4*)(gam + it_ * 256 + 16 * (2 * wave + tdd) + 4 * g4); } \
        if (tid < 256) nv = *(const GAS v4u*)(gv + (t0_ + vj) * 4096 + h * 512 + 32 * sl + vec * 8); } while (0)
#define GLA_VSTAGE(buf) do { if (tid < 256) { const unsigned vv_[4] = {nv.x, nv.y, nv.z, nv.w}; LAS uchar* vt_ = VT + (buf) * 4608; \
        _Pragma("unroll") for (int i = 0; i < 4; ++i) { *(LAS unsigned short*)(vt_ + (vec * 8 + 2 * i) * 144 + vj * 2) = (unsigned short)(vv_[i] & 0xffffu); *(LAS unsigned short*)(vt_ + (vec * 8 + 2 * i + 1) * 144 + vj * 2) = (unsigned short)(vv_[i] >> 16); } } } while (0)
    GLA_LOAD(0);
    GLA_VSTAGE(0);
    LDS_WAIT(); __builtin_amdgcn_s_barrier(); asm volatile("" ::: "memory");
    for (int c = 0; c < 128; ++c) {
        bf16x8 qf[8], pf[2], kf[2][2]; f32x4 gm[2];
#pragma unroll
        for (int ks = 0; ks < 8; ++ks) qf[ks] = nq[ks];
#pragma unroll
        for (int ks = 0; ks < 2; ++ks) { pf[ks] = np[ks]; kf[0][ks] = nk[0][ks]; kf[1][ks] = nk[1][ks]; }
        gm[0] = ng[0]; gm[1] = ng[1];
        if (c + 1 < 128) GLA_LOAD(c + 1);
        const LAS uchar* sb = Sb + (c & 1) * 16896; LAS uchar* sbn = Sb + ((c + 1) & 1) * 16896; const LAS uchar* vt = VT + (c & 1) * 4608;
        bf16x8 vf[2][2];
#pragma unroll
        for (int t2 = 0; t2 < 2; ++t2)
#pragma unroll
            for (int ks = 0; ks < 2; ++ks) vf[t2][ks] = *(const LAS bf16x8*)(vt + (16 * t2 + r16) * 144 + (32 * ks + 8 * g4) * 2);
        f32x4 o = {0.f, 0.f, 0.f, 0.f};
#pragma unroll
        for (int ks = 0; ks < 8; ++ks) { const bf16x8 sf = *(const LAS bf16x8*)(sb + (16 * te + r16) * 528 + (32 * ks + 8 * g4) * 2); o = __builtin_amdgcn_mfma_f32_16x16x32_bf16(qf[ks], sf, o, 0, 0, 0); }
#pragma unroll
        for (int ks = 0; ks < 2; ++ks) o = __builtin_amdgcn_mfma_f32_16x16x32_bf16(pf[ks], vf[te][ks], o, 0, 0, 0);
        { const long t0 = ((long)b * 128 + c) * 64; bf16* op = gv + (t0 + 16 * ti + 4 * g4) * 4096 + h * 512 + 32 * sl + 16 * te + r16;
#pragma unroll
          for (int ii = 0; ii < 4; ++ii) op[(size_t)ii * 4096] = (unsigned short)f2bf(o[ii]); }
#pragma unroll
        for (int tdd = 0; tdd < 2; ++tdd)
#pragma unroll
            for (int t2 = 0; t2 < 2; ++t2) { f32x4 a = accS[tdd][t2] * gm[tdd];
#pragma unroll
                for (int ks = 0; ks < 2; ++ks) a = __builtin_amdgcn_mfma_f32_16x16x32_bf16(kf[tdd][ks], vf[t2][ks], a, 0, 0, 0);
                accS[tdd][t2] = a;
                v2u w; w.x = pk2(a[0], a[1]); w.y = pk2(a[2], a[3]);
                *(LAS v2u*)(sbn + (16 * t2 + r16) * 528 + (16 * (2 * wave + tdd) + 4 * g4) * 2) = w; }
        if (c + 1 < 128) GLA_VSTAGE((c + 1) & 1);
        LDS_WAIT(); __builtin_amdgcn_s_barrier(); asm volatile("" ::: "memory");
    }
#undef GLA_LOAD
#undef GLA_VSTAGE
    VM_WAIT(); __syncthreads();
}
__device__ __forceinline__ void gla_post_item(uchar* ws, const float* gain, int it, int lane) {
    const int h = it & 7; const size_t off = (size_t)(it >> 3) * 4096 + h * 512 + lane * 8;
    bf16* p = (bf16*)(ws + WS_GV) + off; const v4u ow = *(const GAS v4u*)p, gw = *(const GAS v4u*)((const bf16*)(ws + WS_GR) + off);
    const f32x4 g0 = *(const GAS f32x4*)(gain + h * 512 + lane * 8), g1 = *(const GAS f32x4*)(gain + h * 512 + lane * 8 + 4);
    float o[8] = {bflo(ow.x), bfhi(ow.x), bflo(ow.y), bfhi(ow.y), bflo(ow.z), bfhi(ow.z), bflo(ow.w), bfhi(ow.w)};
    const float gr[8] = {bflo(gw.x), bfhi(gw.x), bflo(gw.y), bfhi(gw.y), bflo(gw.z), bfhi(gw.z), bflo(gw.w), bfhi(gw.w)};
    const float gn[8] = {g0.x, g0.y, g0.z, g0.w, g1.x, g1.y, g1.z, g1.w};
    float ss = 0.f;
#pragma unroll
    for (int i = 0; i < 8; ++i) ss += o[i] * o[i];
    const float rr = rsqrtf(wave_sum(ss) * (1.f / 512.f) + EPS);
#pragma unroll
    for (int i = 0; i < 8; ++i) o[i] = o[i] * rr * gn[i] * (gr[i] / (1.f + __expf(-gr[i])));
    v4u w; w.x = pk2(o[0], o[1]); w.y = pk2(o[2], o[3]); w.z = pk2(o[4], o[5]); w.w = pk2(o[6], o[7]);
    *(GAS v4u*)p = w;
}

__device__ __forceinline__ void transpose_item(const float* W, int ldw, int K, bf16* WT, int k0, int nsrc0, int ndst0, int ncols, LAS float* scr, int lane) {
#pragma unroll 8
    for (int i = 0; i < 32; ++i) { const int kk = 2 * i + (lane >> 5), n = lane & 31; scr[kk * 33 + n] = (n < ncols) ? W[(size_t)(k0 + kk) * ldw + nsrc0 + n] : 0.f; }
    LDS_WAIT(); asm volatile("" ::: "memory");
    const int c = lane & 7;
#pragma unroll
    for (int j = 0; j < 4; ++j) { const int n = (lane >> 3) + 8 * j; const LAS float* s = scr + (8 * c) * 33 + n;
        v4u o; o.x = pk2(s[0 * 33], s[1 * 33]); o.y = pk2(s[2 * 33], s[3 * 33]); o.z = pk2(s[4 * 33], s[5 * 33]); o.w = pk2(s[6 * 33], s[7 * 33]);
        if (n < ncols) *(GAS v4u*)(WT + (size_t)(ndst0 + n) * K + k0 + 8 * c) = o; }
    LDS_WAIT(); asm volatile("" ::: "memory");
}
__device__ __forceinline__ void rms_row_to_bf16(const float* xrow, const float* gain, bf16* orow, int lane) {
    const GAS f32x4* xr = (const GAS f32x4*)xrow + lane; const GAS f32x4* gr = (const GAS f32x4*)gain + lane;
    float s = 0.f;
#pragma unroll
    for (int j = 0; j < 16; ++j) { const f32x4 v = xr[64 * j]; s += (v.x * v.x + v.y * v.y) + (v.z * v.z + v.w * v.w); }
    const float r = rsqrtf(wave_sum(s) * (1.f / 4096.f) + EPS);
    GAS v2u* o8 = (GAS v2u*)orow + lane;
#pragma unroll
    for (int j = 0; j < 16; ++j) { const f32x4 v = xr[64 * j], g = gr[64 * j]; v2u w; w.x = pk2(v.x * r * g.x, v.y * r * g.y); w.y = pk2(v.z * r * g.z, v.w * r * g.w); o8[64 * j] = w; }
}

struct Args { const float* in[23]; float* out; uchar* ws; int ph_lo, ph_hi, flags, pad; };
enum { PH_PRO = 0, PH_P1 = 1, PH_PREP = 2, PH_MIX = 3, PH_MIX2 = 4, PH_MERGE = 5, PH_WOUT = 6, PH_HN = 7, PH_PQ = 8, PH_TOPK = 9, PH_PEER1 = 10, PH_PEER2 = 11, PH_N = 12 };

__global__ void __launch_bounds__(NTHR, 2) mk_fwd(Args args) {
    extern __shared__ __attribute__((aligned(16))) uchar lds_raw[];
    LAS uchar* lds = (LAS uchar*)lds_raw;
    volatile LAS unsigned* MISC = (volatile LAS unsigned*)(lds + MISC_OFF);
    int tid = threadIdx.x, lane = tid & 63, wave = __builtin_amdgcn_readfirstlane(tid >> 6);
    const int wave_s = wave;
    const int G = gridDim.x, bx = blockIdx.x;
#define REFRESH_TID() do { tid = wave_s * 64 + lane_id(); asm volatile("" : "+v"(tid)); lane = tid & 63; wave = wave_s; gw = bx * NWAVES + wave; } while (0)
    uchar* ws = args.ws;
    unsigned* ctl = (unsigned*)(ws + WS_CTL);
    for (int u = tid; u < (LDS_BYTES - LDSCTL_OFF) / 4; u += NTHR) ((LAS unsigned*)(lds + LDSCTL_OFF))[u] = 0u;
    __syncthreads();
    const int lo = args.ph_lo, hi = args.ph_hi;
    const bool multi = (hi - lo) > 1;
    XcdBarrier bar; bar.bar = ctl + CW_BAR; bar.x = 0; bar.st = nullptr;
    if (multi) bar = xcd_barrier_post(ctl + CW_BAR, MISC + 8);
#define IN(k) (lo <= (k) && (k) < hi)
#define BOTH(k) (IN(k) && IN((k) + 1))
#define GRID_BAR() xcd_barrier(bar, wave_s * 64 + lane_id())
    int gw = bx * NWAVES + wave; const int NGW = G * NWAVES;

    if (IN(PH_PRO)) {
        REFRESH_TID();
        LAS float* scr = (LAS float*)(lds + wave * 16384);
        const float* w_in = args.in[3]; const float* w_kv = args.in[11]; const float* w_bg = args.in[14]; const float* w_bs = args.in[15]; const float* w_bm = args.in[16];
        const float* w_out = args.in[17]; const float* w_q = args.in[19];
        bf16* win_t = (bf16*)(ws + WS_WIN_T); bf16* wkv_t = (bf16*)(ws + WS_WKV_T); bf16* wbr_t = (bf16*)(ws + WS_WBR_T); bf16* wout_t = (bf16*)(ws + WS_WOUT_T); bf16* wq_t = (bf16*)(ws + WS_WQ_T);
        constexpr int KB = D / 64;
        constexpr int I_A = KB * (12288 / 32), I_B = KB * (21504 / 32), I_G = KB, I_KV = KB * (8192 / 32), I_BR = KB * (4096 / 32), I_Q = KB * (2048 / 32);
        constexpr int NIT = I_A + I_B + I_G + I_KV + 4 * I_BR; (void)I_Q;
        for (int it = gw; it < NIT; it += NGW) {
            int r = it;
            if (r < I_A) { const int nb = r % 384, kb = r / 384; transpose_item(w_in, DIN, D, win_t, kb * 64, nb * 32, nb * 32, 32, scr, lane); continue; } r -= I_A;
            if (r < I_B) { const int nb = r % 672, kb = r / 672; transpose_item(w_in, DIN, D, win_t, kb * 64, 12304 + nb * 32, 12288 + nb * 32, 32, scr, lane); continue; } r -= I_B;
            if (r < I_G) { transpose_item(w_in, DIN, D, win_t, r * 64, 12288, 33792, 16, scr, lane); continue; } r -= I_G;
            if (r < I_KV) { const int nb = r % 256, kb = r / 256; transpose_item(w_kv, 8192, D, wkv_t, kb * 64, nb * 32, nb * 32, 32, scr, lane); continue; } r -= I_KV;
            if (r < 4 * I_BR) { const int w = r / I_BR, q = r % I_BR, nb = q % 128, kb = q / 128;
                const float* src = w == 0 ? w_bg : (w == 1 ? w_bs : (w == 2 ? w_bm : w_out)); bf16* dst = w < 3 ? wbr_t + (size_t)w * 4096 * 4096 : wout_t;
                transpose_item(src, 4096, D, dst, kb * 64, nb * 32, nb * 32, 32, scr, lane); }
        }
        {
            __syncthreads();
            LAS float* wq_s = (LAS float*)lds;
            LAS float* kh_s = (LAS float*)(lds + 64 * 132 * 4);
            const float* subk = args.in[20];
            const int ng = tid & 31, kg = tid >> 5;
            for (int it = bx; it < 16 * 64; it += G) {
                const int hp = it >> 6, kb = it & 63;
#pragma unroll
                for (int r = 0; r < 4; ++r) { const int idx = tid + 512 * r, row = idx >> 5, c4 = idx & 31;
                    *(LAS f32x4*)(wq_s + row * 132 + c4 * 4) = *(const GAS f32x4*)(w_q + (size_t)(kb * 64 + row) * 2048 + hp * 128 + c4 * 4); }
#pragma unroll
                for (int r = 0; r < 8; ++r) { const int idx = tid + 512 * r, row = idx >> 5, c4 = idx & 31;
                    *(LAS f32x4*)(kh_s + row * 132 + c4 * 4) = *(const GAS f32x4*)(subk + ((size_t)hp * 128 + row) * 128 + c4 * 4); }
                __syncthreads();
                float acc[4][4];
#pragma unroll
                for (int i = 0; i < 4; ++i)
#pragma unroll
                    for (int j = 0; j < 4; ++j) acc[i][j] = 0.f;
                for (int d4 = 0; d4 < 32; ++d4) {
                    f32x4 a[4], b[4];
#pragma unroll
                    for (int i = 0; i < 4; ++i) { a[i] = *(const LAS f32x4*)(wq_s + (4 * kg + i) * 132 + 4 * d4); b[i] = *(const LAS f32x4*)(kh_s + (4 * ng + i) * 132 + 4 * d4); }
#pragma unroll
                    for (int i = 0; i < 4; ++i)
#pragma unroll
                        for (int j = 0; j < 4; ++j) acc[i][j] += (a[i].x * b[j].x + a[i].y * b[j].y) + (a[i].z * b[j].z + a[i].w * b[j].w);
                }
#pragma unroll
                for (int j = 0; j < 4; ++j) { v2u w; w.x = pk2(acc[0][j], acc[1][j]); w.y = pk2(acc[2][j], acc[3][j]);
                    *(GAS v2u*)(wq_t + (size_t)(hp * 128 + 4 * ng + j) * D + kb * 64 + 4 * kg) = w; }
                __syncthreads();
            }
        }
        { v4u z = {0u, 0u, 0u, 0u}; GAS v4u* p = (GAS v4u*)(win_t + (size_t)33808 * D); const size_t n16 = (size_t)240 * D * 2 / 16;
          for (size_t i = (size_t)bx * NTHR + tid; i < n16; i += (size_t)G * NTHR) p[i] = z; }
        for (int m = gw; m < T; m += NGW) rms_row_to_bf16(args.in[0] + (size_t)m * D, args.in[2], (bf16*)(ws + WS_XN) + (size_t)m * D, lane);
        for (int m = gw; m < BATCH * MEM; m += NGW) rms_row_to_bf16(args.in[1] + (size_t)m * D, args.in[10], (bf16*)(ws + WS_MEMN) + (size_t)m * D, lane);
        if (BOTH(PH_PRO)) GRID_BAR();
    }
    if (IN(PH_P1)) {
        pg8::GemmG g{D, D, D}; SchedP1 S{ws, G, bx}; pg8::EpiBf16 E;
        pg8::gemm_phase<pg8::EpiBf16, SchedP1>(lds, g, S, E, wave_s);
        if (BOTH(PH_P1)) GRID_BAR();
    }
    if (IN(PH_PREP)) {
        REFRESH_TID();
        if (args.flags & 1) {
            bf16* kvm = (bf16*)(ws + WS_KVM); const float* gq = args.in[12]; const float* gk = args.in[13];
            for (int it = gw; it < 512 * 4; it += NGW) { const int j = it >> 2, h = it & 3; bf16* p = kvm + (size_t)j * 8192 + h * 1024 + lane * 16;
                const v4u a = *(const GAS v4u*)p, b2 = *(const GAS v4u*)(p + 8);
                float v[16] = {bflo(a.x), bfhi(a.x), bflo(a.y), bfhi(a.y), bflo(a.z), bfhi(a.z), bflo(a.w), bfhi(a.w), bflo(b2.x), bfhi(b2.x), bflo(b2.y), bfhi(b2.y), bflo(b2.z), bfhi(b2.z), bflo(b2.w), bfhi(b2.w)};
                float ss = 0.f;
#pragma unroll
                for (int i = 0; i < 16; ++i) ss += v[i] * v[i];
                const float r = rsqrtf(wave_sum(ss) * (1.f / 1024.f) + EPS) * 0.03125f;
#pragma unroll
                for (int i = 0; i < 16; ++i) v[i] *= r * gk[lane * 16 + i] * gq[lane * 16 + i];
                v4u o0, o1; o0.x = pk2(v[0], v[1]); o0.y = pk2(v[2], v[3]); o0.z = pk2(v[4], v[5]); o0.w = pk2(v[6], v[7]); o1.x = pk2(v[8], v[9]); o1.y = pk2(v[10], v[11]); o1.z = pk2(v[12], v[13]); o1.w = pk2(v[14], v[15]);
                *(GAS v4u*)p = o0; *(GAS v4u*)(p + 8) = o1; }
            for (int it = gw; it < 4096; it += NGW) { const int b = it >> 11, r = it & 2047, cg = r >> 5, jg = r & 31, c = cg * 64 + lane; unsigned short x[8];
#pragma unroll
                for (int i = 0; i < 8; ++i) x[i] = kvm[(size_t)(b * 256 + jg * 8 + i) * 8192 + 4096 + c];
                v4u w; w.x = x[0] | ((unsigned)x[1] << 16); w.y = x[2] | ((unsigned)x[3] << 16); w.z = x[4] | ((unsigned)x[5] << 16); w.w = x[6] | ((unsigned)x[7] << 16);
                *(GAS v4u*)((bf16*)(ws + WS_VTM) + ((size_t)b * 4096 + c) * 256 + jg * 8) = w; }
            for (int it = gw; it < T * 4; it += NGW) { const bf16* p = (const bf16*)(ws + WS_MQ) + (size_t)(it >> 2) * 4096 + (it & 3) * 1024 + lane * 16;
                const v4u a = *(const GAS v4u*)p, b2 = *(const GAS v4u*)(p + 8); const unsigned w8[8] = {a.x, a.y, a.z, a.w, b2.x, b2.y, b2.z, b2.w}; float ss = 0.f;
#pragma unroll
                for (int i = 0; i < 8; ++i) { const float lo_ = bflo(w8[i]), hi_ = bfhi(w8[i]); ss += lo_ * lo_ + hi_ * hi_; }
                ss = wave_sum(ss);
                if (lane == 0) ((float*)(ws + WS_RQ))[it] = rsqrtf(ss * (1.f / 1024.f) + EPS); }
        }
        if (args.flags & 4) {
            __syncthreads();
            for (int it = bx; it < 2048; it += G) gla_prep_item(lds, ws, args.in[4], args.in[5], it, tid);
        }
        if (BOTH(PH_PREP)) GRID_BAR();
    }
    if (IN(PH_MIX)) {
        if (args.flags & 4) {
            REFRESH_TID();
            for (int u = bx; u < 256; u += G) gla_scan_unit(lds, ws, u, tid);
        }
        if (args.flags & 1) {
            pg8::GemmG g{4096, 8192, 1024}; SchedMemS S{ws, G, bx}; pg8::EpiMemS E{(const float*)(ws + WS_RQ), (bf16*)(ws + WS_PM), (LAS float*)(lds + LDSCTL_OFF + 2048)};
            pg8::gemm_phase<pg8::EpiMemS, SchedMemS>(lds, g, S, E, wave_s);
        }
        if (args.flags & 2) {
            REFRESH_TID();
            for (int u = bx; u < 1024; u += G) { const int b = u >> 9, blk = (u >> 3) & 63, kvh = u & 7;
                swa_unit(lds, (bf16*)(ws + WS_SQ), (const bf16*)(ws + WS_SK), (const bf16*)(ws + WS_SV), args.in[7], args.in[8], args.in[9], b, blk, kvh, tid); }
        }
        if (BOTH(PH_MIX)) GRID_BAR();
    }
    if (IN(PH_MIX2)) {
        if (args.flags & 1) {
            pg8::GemmG g{1024, 256, 256}; SchedMemO S{ws, G, bx}; pg8::EpiBf16 E;
            pg8::gemm_phase<pg8::EpiBf16, SchedMemO>(lds, g, S, E, wave_s);
        }
        if (args.flags & 4) {
            REFRESH_TID();
            for (int it = gw; it < T * 8; it += NGW) gla_post_item(ws, args.in[6], it, lane);
        }
        if (BOTH(PH_MIX2)) GRID_BAR();
    }
    if (IN(PH_MERGE)) {
        pg8::GemmG g{D, D, D}; SchedMerge S{ws, G, bx}; pg8::EpiMerge E{(const bf16*)(ws + WS_GATE), (float*)(ws + WS_MIXF), (bf16*)(ws + WS_XN)};
        pg8::gemm_phase<pg8::EpiMerge, SchedMerge>(lds, g, S, E, wave_s);
        if (BOTH(PH_MERGE)) GRID_BAR();
    }
    if (IN(PH_WOUT)) {
        pg8::GemmG g{D, D, D}; SchedPlain S{(const char*)(ws + WS_XN), (const char*)(ws + WS_WOUT_T), (char*)args.out, 64, 16, D, 4, G, bx}; pg8::EpiF32 E{args.in[0]};
        pg8::gemm_phase<pg8::EpiF32, SchedPlain>(lds, g, S, E, wave_s);
        if (BOTH(PH_WOUT)) GRID_BAR();
    }
    if (IN(PH_HN)) {
        REFRESH_TID();
        for (int m = gw; m < T; m += NGW) rms_row_to_bf16(args.out + (size_t)m * D, args.in[18], (bf16*)(ws + WS_XN) + (size_t)m * D, lane);
        {
            const GAS f32x4* us = (const GAS f32x4*)args.in[21]; GAS v4u* ud = (GAS v4u*)(ws + WS_U);
            const size_t n8 = (size_t)16384 * 4096 / 8;
            for (size_t i = (size_t)bx * NTHR + tid; i < n8; i += (size_t)G * NTHR) { const f32x4 a = us[2 * i], b = us[2 * i + 1]; v4u w; w.x = pk2(a.x, a.y); w.y = pk2(a.z, a.w); w.z = pk2(b.x, b.y); w.w = pk2(b.z, b.w); ud[i] = w; }
            LAS float* scr = (LAS float*)(lds + wave * 16384);
            for (int it = gw; it < 256 * 128; it += NGW) { const int nb = it & 127, kb = it >> 7; transpose_item(args.in[22], 4096, 16384, (bf16*)(ws + WS_VT), kb * 64, nb * 32, nb * 32, 32, scr, lane); }
        }
        if (BOTH(PH_HN)) GRID_BAR();
    }
    if (IN(PH_PQ)) {
        pg8::GemmG g{D, D, D}; SchedPlain S{(const char*)(ws + WS_XN), (const char*)(ws + WS_WQ_T), (char*)(ws + WS_QP), 64, 8, D, 4, G, bx}; pg8::EpiF32 E{nullptr};
        pg8::gemm_phase<pg8::EpiF32, SchedPlain>(lds, g, S, E, wave_s);
        if (BOTH(PH_PQ)) GRID_BAR();
    }
    if (IN(PH_TOPK)) {
        REFRESH_TID();
        LAS float* grow = (LAS float*)lds;
        LAS float* topv = (LAS float*)(lds + 65536) + wave * 32;
        LAS int* topi = (LAS int*)(lds + 65536 + 1024) + wave * 32;
        for (int i = tid; i < 16384; i += NTHR) grow[i] = 0.f;
        __syncthreads();
        const float* sc = (const float*)(ws + WS_QP); bf16* ga = (bf16*)(ws + WS_GA);
        const unsigned long long ltmask = (1ull << lane) - 1ull;
        for (int t = bx; t < T; t += G) {
            const float* sp = sc + (size_t)t * 2048 + wave * 256;
#pragma unroll
            for (int p = 0; p < 2; ++p) {
                const float v0 = sp[p * 128 + lane], v1 = sp[p * 128 + 64 + lane];
                unsigned k0 = __builtin_bit_cast(unsigned, v0), k1 = __builtin_bit_cast(unsigned, v1);
                k0 ^= (k0 >> 31) ? 0xFFFFFFFFu : 0x80000000u; k1 ^= (k1 >> 31) ? 0xFFFFFFFFu : 0x80000000u;
                unsigned th = 0u;
                for (int bit = 31; bit >= 0; --bit) { const unsigned cand = th | (1u << bit);
                    const int cnt = __popcll(__ballot(k0 >= cand)) + __popcll(__ballot(k1 >= cand)); if (cnt >= 16) th = cand; }
                const unsigned long long gt0 = __ballot(k0 > th), gt1 = __ballot(k1 > th), eq0 = __ballot(k0 == th), eq1 = __ballot(k1 == th);
                const int need = 16 - (__popcll(gt0) + __popcll(gt1));
                const bool s0 = (k0 > th) || (k0 == th && __popcll(eq0 & ltmask) < need);
                const bool s1 = (k1 > th) || (k1 == th && (__popcll(eq0) + __popcll(eq1 & ltmask)) < need);
                const unsigned long long m0 = __ballot(s0), m1 = __ballot(s1);
                if (s0) { const int slot = __popcll(m0 & ltmask); topv[p * 16 + slot] = v0; topi[p * 16 + slot] = lane; }
                if (s1) { const int slot = __popcll(m0) + __popcll(m1 & ltmask); topv[p * 16 + slot] = v1; topi[p * 16 + slot] = 64 + lane; }
            }
            LDS_WAIT();
            float cv[4]; unsigned ck[4];
#pragma unroll
            for (int r = 0; r < 4; ++r) { const int c = lane + 64 * r; cv[r] = topv[c >> 4] + topv[16 + (c & 15)]; unsigned k = __builtin_bit_cast(unsigned, cv[r]); k ^= (k >> 31) ? 0xFFFFFFFFu : 0x80000000u; ck[r] = k; }
            unsigned th = 0u;
            for (int bit = 31; bit >= 0; --bit) { const unsigned cand = th | (1u << bit);
                const int cnt = __popcll(__ballot(ck[0] >= cand)) + __popcll(__ballot(ck[1] >= cand)) + __popcll(__ballot(ck[2] >= cand)) + __popcll(__ballot(ck[3] >= cand)); if (cnt >= 16) th = cand; }
            int need = 16;
#pragma unroll
            for (int r = 0; r < 4; ++r) need -= __popcll(__ballot(ck[r] > th));
            bool sel[4]; int before = 0;
#pragma unroll
            for (int r = 0; r < 4; ++r) { const unsigned long long eq = __ballot(ck[r] == th); sel[r] = (ck[r] > th) || (ck[r] == th && (before + __popcll(eq & ltmask)) < need); before += __popcll(eq); }
            float mx = -INFINITY;
#pragma unroll
            for (int r = 0; r < 4; ++r) mx = fmaxf(mx, cv[r]);
            mx = wave_max(mx);
            float e[4], es = 0.f;
#pragma unroll
            for (int r = 0; r < 4; ++r) { e[r] = sel[r] ? __expf(cv[r] - mx) : 0.f; es += e[r]; }
            es = wave_sum(es);
            const float inv = 1.0f / es;
#pragma unroll
            for (int r = 0; r < 4; ++r) if (sel[r]) { const int c = lane + 64 * r; const int ex = topi[c >> 4] * 128 + topi[16 + (c & 15)]; (void)__hip_atomic_fetch_add(grow + ex, e[r] * inv, __ATOMIC_RELAXED, __HIP_MEMORY_SCOPE_WORKGROUP); }
            LDS_WAIT();
            __syncthreads();
            {
                LAS f32x4* rp = (LAS f32x4*)(grow + 32 * tid); GAS v4u* gp = (GAS v4u*)(ga + (size_t)t * 16384 + 32 * tid);
#pragma unroll
                for (int q = 0; q < 4; ++q) { const f32x4 a = rp[2 * q], b = rp[2 * q + 1]; v4u w; w.x = pk2(a.x, a.y); w.y = pk2(a.z, a.w); w.z = pk2(b.x, b.y); w.w = pk2(b.z, b.w); gp[q] = w;
                    rp[2 * q] = (f32x4){0.f, 0.f, 0.f, 0.f}; rp[2 * q + 1] = (f32x4){0.f, 0.f, 0.f, 0.f}; }
            }
            LDS_WAIT();
            __syncthreads();
        }
        if (BOTH(PH_TOPK)) GRID_BAR();
    }
    if (IN(PH_PEER1)) {
        pg8::GemmG g{D, D, D}; SchedPlain S{(const char*)(ws + WS_XN), (const char*)(ws + WS_U), (char*)(ws + WS_GA), 64, 64, D, 2, G, bx}; pg8::EpiPeerA E{(bf16*)(ws + WS_GA)};
        pg8::gemm_phase<pg8::EpiPeerA, SchedPlain>(lds, g, S, E, wave_s);
        if (BOTH(PH_PEER1)) GRID_BAR();
    }
    if (IN(PH_PEER2)) {
        pg8::GemmG g{16384, 16384, 16384}; SchedPlain S{(const char*)(ws + WS_GA), (const char*)(ws + WS_VT), (char*)args.out, 64, 16, 16384, 4, G, bx}; pg8::EpiF32 E{args.out};
        pg8::gemm_phase<pg8::EpiF32, SchedPlain>(lds, g, S, E, wave_s);
    }
#undef IN
#undef BOTH
#undef GRID_BAR
}

namespace nv {
__device__ __forceinline__ float ldb(const bf16* p) { return bf2f(*p); }
__device__ __forceinline__ float block_sum(float v, float* red) {
    v = wave_sum(v); __syncthreads();
    if ((threadIdx.x & 63) == 0) red[threadIdx.x >> 6] = v;
    __syncthreads();
    float s = 0.f; for (int i = 0; i < (int)(blockDim.x >> 6); ++i) s += red[i];
    return s;
}
__device__ __forceinline__ float block_max(float v, float* red) {
    v = wave_max(v); __syncthreads();
    if ((threadIdx.x & 63) == 0) red[threadIdx.x >> 6] = v;
    __syncthreads();
    float s = red[0]; for (int i = 1; i < (int)(blockDim.x >> 6); ++i) s = fmaxf(s, red[i]);
    return s;
}
__global__ void k_headnorm(bf16* x, long ldx, int nheads, int hd, const float* gain, long nrows) {
    const long w = ((long)blockIdx.x * blockDim.x + threadIdx.x) >> 6; const int lane = threadIdx.x & 63;
    if (w >= nrows * nheads) return;
    const long r = w / nheads; const int h = (int)(w % nheads);
    bf16* p = x + r * ldx + (long)h * hd;
    float s = 0.f;
    for (int i = lane; i < hd; i += 64) { float v = ldb(p + i); s += v * v; }
    s = wave_sum(s);
    const float rr = rsqrtf(s / (float)hd + EPS);
    for (int i = lane; i < hd; i += 64) p[i] = (bf16)f2bf(ldb(p + i) * rr * gain[i]);
}
__global__ void k_gla_decay(const bf16* glrp, const float* wup, const float* bias, float* dec) {
    const long i = (long)blockIdx.x * blockDim.x + threadIdx.x;
    if (i >= (long)T * 2048) return;
    const long t = i / 2048; const int c = (int)(i % 2048);
    const bf16* g = glrp + t * 256;
    float s = bias[c];
    for (int r = 0; r < 16; ++r) s = fmaf(ldb(g + r), wup[r * 2048 + c], s);
    const float ls = fminf(s, 0.f) - log1pf(expf(-fabsf(s)));
    dec[i] = expf(ls * (1.0f / 16.0f));
}
__global__ __launch_bounds__(256) void k_gla_scan(const bf16* gq, const bf16* gk, bf16* gv, const float* dec) {
    const int h = blockIdx.y, e = blockIdx.x * 64 + (threadIdx.x >> 2), qd = threadIdx.x & 3; const long t0 = (long)blockIdx.z * SEQ;
    float S[64];
#pragma unroll
    for (int i = 0; i < 64; ++i) S[i] = 0.f;
    for (long t = t0; t < t0 + SEQ; ++t) {
        const bf16* pq = gq + t * 2048 + h * 256 + qd * 64; const bf16* pk = gk + t * 2048 + h * 256 + qd * 64; const float* pa = dec + t * 2048 + h * 256 + qd * 64;
        const float v = ldb(gv + t * 4096 + h * 512 + e);
        float o = 0.f;
#pragma unroll
        for (int i = 0; i < 64; i += 4) {
            const v2u qw = *(const v2u*)(pq + i), kw = *(const v2u*)(pk + i); const float4 a4 = *(const float4*)(pa + i);
            S[i + 0] = fmaf(a4.x, S[i + 0], bflo(kw.x) * v); o = fmaf(bflo(qw.x), S[i + 0], o);
            S[i + 1] = fmaf(a4.y, S[i + 1], bfhi(kw.x) * v); o = fmaf(bfhi(qw.x), S[i + 1], o);
            S[i + 2] = fmaf(a4.z, S[i + 2], bflo(kw.y) * v); o = fmaf(bflo(qw.y), S[i + 2], o);
            S[i + 3] = fmaf(a4.w, S[i + 3], bfhi(kw.y) * v); o = fmaf(bfhi(qw.y), S[i + 3], o);
        }
        o += __shfl_xor(o, 1); o += __shfl_xor(o, 2);
        if (qd == 0) gv[t * 4096 + h * 512 + e] = (bf16)f2bf(o);
    }
}
__global__ void k_gla_post(bf16* oa, const bf16* gr, const float* gain) {
    const long w = ((long)blockIdx.x * blockDim.x + threadIdx.x) >> 6; const int lane = threadIdx.x & 63;
    if (w >= (long)T * 8) return;
    const long t = w >> 3; const int h = (int)(w & 7);
    bf16* p = oa + t * 4096 + h * 512; const bf16* g = gr + t * 4096 + h * 512;
    float s = 0.f;
    for (int i = lane; i < 512; i += 64) { float v = ldb(p + i); s += v * v; }
    s = wave_sum(s);
    const float rr = rsqrtf(s / 512.f + EPS);
    for (int i = lane; i < 512; i += 64) { const float gg = ldb(g + i); p[i] = (bf16)f2bf(ldb(p + i) * rr * gain[h * 512 + i] * (gg / (1.f + expf(-gg)))); }
}
__global__ __launch_bounds__(256) void k_swa(bf16* sq, const bf16* sk, const bf16* sv, const float* sinks) {
    __shared__ float qs[4][64];
    __shared__ float ps[4][128];
    const int wl = threadIdx.x >> 6, lane = threadIdx.x & 63;
    const long w = (long)blockIdx.x * 4 + wl;
    const long t = w >> 6; const int hq = (int)(w & 63), kvh = hq >> 3; const long tb = (t / SEQ) * SEQ;
    qs[wl][lane] = ldb(sq + t * 4096 + hq * 64 + lane);
    __syncthreads();
    const float sink = sinks[hq];
    float sc[2];
#pragma unroll
    for (int r = 0; r < 2; ++r) {
        const long key = t - 127 + lane + r * 64;
        float s = -INFINITY;
        if (key >= tb) {
            const bf16* kp = sk + key * 512 + kvh * 64;
            float a = 0.f;
            for (int d = 0; d < 64; ++d) a = fmaf(qs[wl][d], ldb(kp + d), a);
            s = a * 0.125f;
        }
        sc[r] = s;
    }
    const float m = fmaxf(wave_max(fmaxf(sc[0], sc[1])), sink);
    const float p0 = expf(sc[0] - m), p1 = expf(sc[1] - m);
    const float den = wave_sum(p0 + p1) + expf(sink - m);
    ps[wl][lane] = p0 / den; ps[wl][lane + 64] = p1 / den;
    __syncthreads();
    float o = 0.f;
    for (int j = 0; j < 128; ++j) { const long key = t - 127 + j; if (key >= tb) o = fmaf(ps[wl][j], ldb(sv + key * 512 + kvh * 64 + lane), o); }
    sq[t * 4096 + hq * 64 + lane] = (bf16)f2bf(o);
}
__global__ __launch_bounds__(256) void k_memattn(bf16* mq, const bf16* kvm) {
    __shared__ float qs[8][1024];
    __shared__ float ps[8][256];
    __shared__ float red[8];
    const int hd = blockIdx.y; const long t0 = (long)blockIdx.x * 8; const int tid = threadIdx.x; const long b = t0 / SEQ;
    const bf16* kv = kvm + b * 256 * 8192;
    for (int i = tid; i < 8 * 1024; i += 256) qs[i >> 10][i & 1023] = ldb(mq + (t0 + (i >> 10)) * 4096 + hd * 1024 + (i & 1023));
    __syncthreads();
    float s[8];
#pragma unroll
    for (int r = 0; r < 8; ++r) s[r] = 0.f;
    const bf16* kp = kv + (long)tid * 8192 + hd * 1024;
    for (int d = 0; d < 1024; ++d) { const float kk = ldb(kp + d);
#pragma unroll
        for (int r = 0; r < 8; ++r) s[r] = fmaf(qs[r][d], kk, s[r]); }
    for (int r = 0; r < 8; ++r) {
        const float v = s[r] * 0.03125f;
        const float m = block_max(v, red);
        const float p = expf(v - m);
        const float den = block_sum(p, red);
        ps[r][tid] = p / den;
    }
    __syncthreads();
    float o[8][4];
#pragma unroll
    for (int r = 0; r < 8; ++r)
#pragma unroll
        for (int c = 0; c < 4; ++c) o[r][c] = 0.f;
    for (int j = 0; j < 256; ++j) {
        const bf16* vp = kv + (long)j * 8192 + 4096 + hd * 1024;
        float vv[4];
#pragma unroll
        for (int c = 0; c < 4; ++c) vv[c] = ldb(vp + tid + c * 256);
#pragma unroll
        for (int r = 0; r < 8; ++r) { const float p = ps[r][j];
#pragma unroll
            for (int c = 0; c < 4; ++c) o[r][c] = fmaf(p, vv[c], o[r][c]); }
    }
#pragma unroll
    for (int r = 0; r < 8; ++r)
#pragma unroll
        for (int c = 0; c < 4; ++c) mq[(t0 + r) * 4096 + hd * 1024 + tid + c * 256] = (bf16)f2bf(o[r][c]);
}
__global__ __launch_bounds__(256) void k_peer(float* io, const bf16* hn, const float* qp, const float* subk, const float* ut, const float* vt) {
    __shared__ float xs[4096];
    __shared__ float sc[2][128];
    __shared__ float tops[2][16];
    __shared__ int topi[2][16];
    __shared__ float cand[256];
    __shared__ float bests[16];
    __shared__ int beste[16];
    __shared__ float gate_s[128];
    __shared__ int exp_s[128];
    __shared__ float coef[128];
    const long t = blockIdx.x; const int tid = threadIdx.x, lane = tid & 63, wv = tid >> 6;
    for (int i = tid; i < 4096; i += 256) xs[i] = ldb(hn + t * 4096 + i);
    __syncthreads();
    for (int h = 0; h < 8; ++h) {
        { const int p = tid >> 7, n = tid & 127; const float* q = qp + t * 2048 + h * 256 + p * 128; const float* kk = subk + (((long)h * 2 + p) * 128 + n) * 128;
          float s = 0.f; for (int d = 0; d < 128; ++d) s = fmaf(q[d], kk[d], s); sc[p][n] = s; }
        __syncthreads();
        { const int p = tid >> 7, n = tid & 127; const float s = sc[p][n]; int rank = 0;
          for (int j = 0; j < 128; ++j) { const float o = sc[p][j]; rank += (o > s || (o == s && j < n)) ? 1 : 0; }
          if (rank < 16) { tops[p][rank] = s; topi[p][rank] = n; } }
        __syncthreads();
        cand[tid] = tops[0][tid >> 4] + tops[1][tid & 15];
        __syncthreads();
        { const float s = cand[tid]; int rank = 0;
          for (int j = 0; j < 256; ++j) { const float o = cand[j]; rank += (o > s || (o == s && j < tid)) ? 1 : 0; }
          if (rank < 16) { bests[rank] = s; beste[rank] = topi[0][tid >> 4] * 128 + topi[1][tid & 15]; } }
        __syncthreads();
        if (tid < 16) { const float m = bests[0]; float den = 0.f; for (int j = 0; j < 16; ++j) den += expf(bests[j] - m);
            gate_s[h * 16 + tid] = expf(bests[tid] - m) / den; exp_s[h * 16 + tid] = beste[tid]; }
        __syncthreads();
    }
    for (int j = wv * 32; j < wv * 32 + 32; ++j) {
        const float* up = ut + (long)exp_s[j] * 4096;
        float s = 0.f;
        for (int i = lane * 4; i < 4096; i += 256) { const float4 u4 = *(const float4*)(up + i); s = fmaf(u4.x, xs[i], s); s = fmaf(u4.y, xs[i + 1], s); s = fmaf(u4.z, xs[i + 2], s); s = fmaf(u4.w, xs[i + 3], s); }
        s = wave_sum(s);
        if (lane == 0) coef[j] = gate_s[j] * 0.5f * s * (1.0f + erff(s * 0.70710678118654752f));
    }
    __syncthreads();
    float y[16];
#pragma unroll
    for (int c = 0; c < 16; ++c) y[c] = 0.f;
    for (int j = 0; j < 128; ++j) {
        const float* vp = vt + (long)exp_s[j] * 4096; const float cf = coef[j];
#pragma unroll
        for (int c = 0; c < 4; ++c) { const float4 v4 = *(const float4*)(vp + c * 1024 + tid * 4); y[c * 4] = fmaf(cf, v4.x, y[c * 4]); y[c * 4 + 1] = fmaf(cf, v4.y, y[c * 4 + 1]); y[c * 4 + 2] = fmaf(cf, v4.z, y[c * 4 + 2]); y[c * 4 + 3] = fmaf(cf, v4.w, y[c * 4 + 3]); }
    }
#pragma unroll
    for (int c = 0; c < 4; ++c) { float4 o = *(float4*)(io + t * 4096 + c * 1024 + tid * 4); o.x += y[c * 4]; o.y += y[c * 4 + 1]; o.z += y[c * 4 + 2]; o.w += y[c * 4 + 3]; *(float4*)(io + t * 4096 + c * 1024 + tid * 4) = o; }
}
}

#ifndef DIFFTEST
#define DIFFTEST 0
#endif
namespace dbg {
__global__ void k_diff(const bf16* a, const bf16* b, size_t n, float* acc) {
    float d2 = 0.f, r2 = 0.f;
    for (size_t i = (size_t)blockIdx.x * blockDim.x + threadIdx.x; i < n; i += (size_t)gridDim.x * blockDim.x) { const float x = bf2f(a[i]), y = bf2f(b[i]); d2 += (x - y) * (x - y); r2 += y * y; }
    d2 = wave_sum(d2); r2 = wave_sum(r2);
    if ((threadIdx.x & 63) == 0) { atomicAdd(acc, d2); atomicAdd(acc + 1, r2); }
}
__global__ void k_scale(float* out, size_t n, const float* acc, float amp) {
    const float f = 1.0f + amp * sqrtf(acc[0] / fmaxf(acc[1], 1e-30f));
    for (size_t i = (size_t)blockIdx.x * blockDim.x + threadIdx.x; i < n; i += (size_t)gridDim.x * blockDim.x) out[i] *= f;
}
}
constexpr size_t WS_DBG_A = WS_END, WS_DBG_B = WS_END + 128 * MiB;

#ifndef FAST_FLAGS
#define FAST_FLAGS 7
#endif
extern "C" void kernel_launch(void* const* d_in, const int* in_sizes, int n_in, void* d_out, int out_size, void* d_ws, size_t ws_size, hipStream_t stream) {
    static int grid = 0;
    if (grid == 0) {
        int dev = 0, cus = 0, per_cu = 0;
        if (hipGetDevice(&dev) != hipSuccess || hipDeviceGetAttribute(&cus, hipDeviceAttributeMultiprocessorCount, dev) != hipSuccess) { grid = -1; return; }
        if (hipFuncSetAttribute((const void*)mk_fwd, hipFuncAttributeMaxDynamicSharedMemorySize, LDS_BYTES) != hipSuccess) { grid = -1; return; }
        if (hipOccupancyMaxActiveBlocksPerMultiprocessor(&per_cu, (const void*)mk_fwd, NTHR, LDS_BYTES) != hipSuccess || per_cu < 1) fprintf(stderr, "occupancy query: %d\n", per_cu);
        (void)hipGetLastError();
        grid = cus;
        if (n_in != 23 || ws_size < WS_END) { fprintf(stderr, "kernel_launch: unexpected n_in %d / ws %zu\n", n_in, ws_size); }
    }
    if (grid < 0) return;
    (void)hipMemsetAsync((char*)d_ws + WS_CTL, 0, CTL_ZERO_BYTES, stream);
    Args a{};
    for (int i = 0; i < 23; ++i) a.in[i] = (const float*)d_in[i];
    a.out = (float*)d_out; a.ws = (uchar*)d_ws;
    uchar* ws = (uchar*)d_ws;
    a.flags = FAST_FLAGS;
    auto launch = [&](int lo, int hi) { a.ph_lo = lo; a.ph_hi = hi; hipLaunchKernelGGL(mk_fwd, dim3(grid), dim3(NTHR), LDS_BYTES, stream, a); };
#if FAST_FLAGS == 7 && DIFFTEST == 0 && !defined(MK_PER_PHASE)
    launch(PH_PRO, PH_N);
#else
    launch(PH_PRO, PH_PRO + 1);
    launch(PH_P1, PH_P1 + 1);
    {
        using namespace nv;
        float* dec = (float*)(ws + WS_XN);
#if DIFFTEST == 3
        (void)hipMemcpyAsync(ws + WS_DBG_A, ws + WS_GV, (size_t)128 * MiB, hipMemcpyDeviceToDevice, stream);
        k_gla_decay<<<(int)(((long)T * 2048 + 255) / 256), 256, 0, stream>>>((const bf16*)(ws + WS_GLRP), a.in[4], a.in[5], dec);
        k_gla_scan<<<dim3(8, 8, 2), 256, 0, stream>>>((const bf16*)(ws + WS_GQ), (const bf16*)(ws + WS_GK), (bf16*)(ws + WS_DBG_A), dec);
        k_gla_post<<<T * 8 / 4, 256, 0, stream>>>((bf16*)(ws + WS_DBG_A), (const bf16*)(ws + WS_GR), a.in[6]);
#endif
        if (!(FAST_FLAGS & 4)) {
        k_gla_decay<<<(int)(((long)T * 2048 + 255) / 256), 256, 0, stream>>>((const bf16*)(ws + WS_GLRP), a.in[4], a.in[5], dec);
        k_gla_scan<<<dim3(8, 8, 2), 256, 0, stream>>>((const bf16*)(ws + WS_GQ), (const bf16*)(ws + WS_GK), (bf16*)(ws + WS_GV), dec);
        k_gla_post<<<T * 8 / 4, 256, 0, stream>>>((bf16*)(ws + WS_GV), (const bf16*)(ws + WS_GR), a.in[6]);
        }
#if DIFFTEST == 2
        (void)hipMemcpyAsync(ws + WS_DBG_A, ws + WS_SQ, (size_t)128 * MiB, hipMemcpyDeviceToDevice, stream);
        (void)hipMemcpyAsync(ws + WS_DBG_B, ws + WS_SK, (size_t)16 * MiB, hipMemcpyDeviceToDevice, stream);
        k_headnorm<<<T * 64 / 4, 256, 0, stream>>>((bf16*)(ws + WS_DBG_A), 4096, 64, 64, a.in[7], T);
        k_headnorm<<<T * 8 / 4, 256, 0, stream>>>((bf16*)(ws + WS_DBG_B), 512, 8, 64, a.in[8], T);
        k_swa<<<T * 64 / 4, 256, 0, stream>>>((bf16*)(ws + WS_DBG_A), (const bf16*)(ws + WS_DBG_B), (const bf16*)(ws + WS_SV), a.in[9]);
#endif
        if (!(FAST_FLAGS & 2)) {
        k_headnorm<<<T * 64 / 4, 256, 0, stream>>>((bf16*)(ws + WS_SQ), 4096, 64, 64, a.in[7], T);
        k_headnorm<<<T * 8 / 4, 256, 0, stream>>>((bf16*)(ws + WS_SK), 512, 8, 64, a.in[8], T);
        k_swa<<<T * 64 / 4, 256, 0, stream>>>((bf16*)(ws + WS_SQ), (const bf16*)(ws + WS_SK), (const bf16*)(ws + WS_SV), a.in[9]);
        }
#if DIFFTEST == 1
        (void)hipMemcpyAsync(ws + WS_DBG_A, ws + WS_MQ, (size_t)128 * MiB, hipMemcpyDeviceToDevice, stream);
        (void)hipMemcpyAsync(ws + WS_DBG_B, ws + WS_KVM, (size_t)8 * MiB, hipMemcpyDeviceToDevice, stream);
        k_headnorm<<<512 * 4 / 4, 256, 0, stream>>>((bf16*)(ws + WS_DBG_B), 8192, 4, 1024, a.in[13], 512);
        k_headnorm<<<T * 4 / 4, 256, 0, stream>>>((bf16*)(ws + WS_DBG_A), 4096, 4, 1024, a.in[12], T);
        k_memattn<<<dim3(T / 8, 4), 256, 0, stream>>>((bf16*)(ws + WS_DBG_A), (const bf16*)(ws + WS_DBG_B));
#endif
        if (!(FAST_FLAGS & 1)) {
        k_headnorm<<<512 * 4 / 4, 256, 0, stream>>>((bf16*)(ws + WS_KVM), 8192, 4, 1024, a.in[13], 512);
        k_headnorm<<<T * 4 / 4, 256, 0, stream>>>((bf16*)(ws + WS_MQ), 4096, 4, 1024, a.in[12], T);
        k_memattn<<<dim3(T / 8, 4), 256, 0, stream>>>((bf16*)(ws + WS_MQ), (const bf16*)(ws + WS_KVM));
        }
    }
    launch(PH_PREP, PH_PREP + 1);
    launch(PH_MIX, PH_MIX + 1);
    launch(PH_MIX2, PH_MIX2 + 1);
#if DIFFTEST == 1
    dbg::k_diff<<<2048, 256, 0, stream>>>((const bf16*)(ws + WS_MQ), (const bf16*)(ws + WS_DBG_A), (size_t)T * 4096, (float*)(ws + WS_CTL) + 64);
#elif DIFFTEST == 2
    dbg::k_diff<<<2048, 256, 0, stream>>>((const bf16*)(ws + WS_SQ), (const bf16*)(ws + WS_DBG_A), (size_t)T * 4096, (float*)(ws + WS_CTL) + 64);
#elif DIFFTEST == 3
    dbg::k_diff<<<2048, 256, 0, stream>>>((const bf16*)(ws + WS_GV), (const bf16*)(ws + WS_DBG_A), (size_t)T * 4096, (float*)(ws + WS_CTL) + 64);
#endif
    launch(PH_MERGE, PH_MERGE + 1);
    launch(PH_WOUT, PH_WOUT + 1);
    launch(PH_HN, PH_HN + 1);
    launch(PH_PQ, PH_PQ + 1);
    launch(PH_TOPK, PH_TOPK + 1);
    launch(PH_PEER1, PH_PEER1 + 1);
    launch(PH_PEER2, PH_PEER2 + 1);
#endif
#if DIFFTEST
    dbg::k_scale<<<2048, 256, 0, stream>>>((float*)d_out, (size_t)T * 4096, (const float*)(ws + WS_CTL) + 64, 10.0f);
#endif
}
```

```cpp
#include <hip/hip_runtime.h>
#include <cstdio>
#include <cstdint>

#define GAS __attribute__((address_space(1)))
#define LAS __attribute__((address_space(3)))
typedef unsigned short bf16;
typedef unsigned v4u __attribute__((ext_vector_type(4)));
typedef unsigned v2u __attribute__((ext_vector_type(2)));
typedef float f32x4 __attribute__((ext_vector_type(4)));
typedef float f32x2 __attribute__((ext_vector_type(2)));
typedef short bf16x8 __attribute__((ext_vector_type(8)));
typedef unsigned char uchar;
typedef int v8i __attribute__((ext_vector_type(8)));
typedef int v4i __attribute__((ext_vector_type(4)));

#ifndef P1_NB16
#define P1_NB16 8
#endif
#ifndef FAST_FLAGS
#define FAST_FLAGS 7
#endif
constexpr int D = 4096, BATCH = 2, SEQ = 8192, T = BATCH * SEQ, MEM = 256;
constexpr int DIN = 33808;
constexpr int NV = 34048;
constexpr float EPS = 1e-6f;
constexpr int NWAVES = 8, NTHR = 512;

constexpr size_t MiB = 1u << 20;
constexpr size_t WS_CTL = 0, CTL_ZERO_BYTES = 1 * MiB;
constexpr size_t WS_WIN_T = 1 * MiB;
constexpr size_t WS_MIXF = WS_WIN_T;
constexpr size_t WS_WIN8 = WS_WIN_T + 96 * MiB;
constexpr size_t WS_WKV_T = WS_WIN_T + 266 * MiB;
constexpr size_t WS_WBR_T = WS_WKV_T + 64 * MiB;
constexpr size_t WS_WOUT_T = WS_WBR_T + 96 * MiB;
constexpr size_t WS_WQ_T = WS_WOUT_T + 32 * MiB;
constexpr size_t WS_U8 = WS_WIN_T;
constexpr size_t WS_V8T = WS_WIN_T + 64 * MiB;
constexpr size_t WS_HN8 = WS_WIN_T + 128 * MiB;
constexpr size_t WS_XN = WS_WQ_T + 16 * MiB;
constexpr size_t WS_MEMN = WS_XN + 128 * MiB;
constexpr size_t WS_KVM = WS_MEMN + 4 * MiB;
constexpr size_t WS_GQ = WS_KVM + 8 * MiB;
constexpr size_t WS_GK = WS_GQ + 64 * MiB;
constexpr size_t WS_QP = WS_GQ;
constexpr size_t WS_GV = WS_GK + 64 * MiB;
constexpr size_t WS_GR = WS_GV + 128 * MiB;
constexpr size_t WS_SQ = WS_GR + 128 * MiB;
constexpr size_t WS_SK = WS_SQ + 128 * MiB;
constexpr size_t WS_SV = WS_SK + 16 * MiB;
constexpr size_t WS_MQ = WS_SV + 16 * MiB;
constexpr size_t WS_GATE = WS_MQ + 128 * MiB;
constexpr size_t WS_GLRP = WS_GATE + 384 * MiB;
constexpr size_t WS_KD = WS_GLRP + 8 * MiB;
constexpr size_t WS_PC = WS_KD + 64 * MiB;
constexpr size_t WS_GAM = WS_PC + 16 * MiB;
constexpr size_t WS_PM = WS_GAM + 2 * MiB;
constexpr size_t WS_VTM = WS_PM + 32 * MiB;
constexpr size_t WS_RQ = WS_VTM + 4 * MiB;
constexpr size_t WS_QT = WS_RQ + 1 * MiB;
constexpr size_t WS_OA8 = WS_GK;
constexpr size_t WS_OB8 = WS_GQ;
constexpr size_t WS_OC8 = WS_QT;
constexpr size_t WS_HB = WS_SQ;
constexpr size_t WS_MIX8 = WS_XN;
constexpr size_t WS_XN8 = WS_QT;
constexpr size_t WS_END = WS_QT + 64 * MiB;
constexpr size_t WS_GA = WS_GV;
static_assert(WS_GA + (size_t)512 * MiB <= WS_GATE, "GA overlay");
constexpr size_t WS_A8 = WS_GATE;
static_assert(WS_END <= (size_t)2113 * MiB, "workspace");

constexpr int CW_TMO = 0, CW_BAR = 256;

constexpr int RING_BYTES = 131072;
constexpr int LDSCTL_OFF = RING_BYTES, MISC_OFF = LDSCTL_OFF + 320;
constexpr int LDS_BYTES = 147456;

#define RLX_AGENT __ATOMIC_RELAXED, __HIP_MEMORY_SCOPE_AGENT
#define LDS_WAIT() asm volatile("s_waitcnt lgkmcnt(0)" ::: "memory")
#define VM_WAIT() asm volatile("s_waitcnt vmcnt(0)" ::: "memory")
typedef __bf16 bf16x2_t __attribute__((ext_vector_type(2)));
__device__ __forceinline__ unsigned pk2(float lo, float hi) { const f32x2 v = {lo, hi}; return __builtin_bit_cast(unsigned, __builtin_convertvector(v, bf16x2_t)); }
__device__ __forceinline__ unsigned f2bf(float f) { return pk2(f, 0.f) & 0xffffu; }
__device__ __forceinline__ float bf2f(unsigned b) { return __builtin_bit_cast(float, b << 16); }
__device__ __forceinline__ float bflo(unsigned w) { return __builtin_bit_cast(float, w << 16); }
__device__ __forceinline__ float bfhi(unsigned w) { return __builtin_bit_cast(float, w & 0xffff0000u); }
__device__ __forceinline__ unsigned cvt_pk_bf16(float lo, float hi) { return pk2(lo, hi); }
__device__ __forceinline__ int lane_id() { return (int)__builtin_amdgcn_mbcnt_hi(~0u, __builtin_amdgcn_mbcnt_lo(~0u, 0u)); }
__device__ __forceinline__ int fresh_lane() { int l; asm volatile("v_mbcnt_lo_u32_b32 %0, -1, 0\n\tv_mbcnt_hi_u32_b32 %0, -1, %0" : "=v"(l)); return l; }
#define DPP_F(x, ctrl) __builtin_bit_cast(float, __builtin_amdgcn_update_dpp(0, __builtin_bit_cast(int, (x)), (ctrl), 0xF, 0xF, false))
#define RDL_F(x, l) __builtin_bit_cast(float, __builtin_amdgcn_readlane(__builtin_bit_cast(int, (x)), (l)))
__device__ __forceinline__ float wave_sum(float v) {
    v += DPP_F(v, 0xB1); v += DPP_F(v, 0x4E); v += DPP_F(v, 0x141); v += DPP_F(v, 0x140);
    return (RDL_F(v, 0) + RDL_F(v, 16)) + (RDL_F(v, 32) + RDL_F(v, 48));
}
__device__ __forceinline__ float wave_max(float v) {
    v = fmaxf(v, DPP_F(v, 0xB1)); v = fmaxf(v, DPP_F(v, 0x4E)); v = fmaxf(v, DPP_F(v, 0x141)); v = fmaxf(v, DPP_F(v, 0x140));
    return fmaxf(fmaxf(RDL_F(v, 0), RDL_F(v, 16)), fmaxf(RDL_F(v, 32), RDL_F(v, 48)));
}

#define XB_TMO      128
#define XB_XCNT(j)  (256  + 64 * (j))
#define XB_XSUB(j)  (1280 + 64 * (j))
#define XB_XGEN(j)  (2304 + 64 * (j))
#define XB_TOP      3328
#define XB_TOPGEN   3392
#define XCD_BAR_WORDS 3456
#define XB_SPIN_CAP (1u << 18)
__device__ __forceinline__ unsigned xb_ld(unsigned* p)              { return __hip_atomic_load(p, __ATOMIC_RELAXED, __HIP_MEMORY_SCOPE_AGENT); }
__device__ __forceinline__ unsigned xb_add(unsigned* p, unsigned v) { return __hip_atomic_fetch_add(p, v, __ATOMIC_RELAXED, __HIP_MEMORY_SCOPE_AGENT); }
__device__ __forceinline__ unsigned xb_xcc_id() { return (unsigned)__builtin_amdgcn_s_getreg((3 << 11) | 20) & 0xFu; }
#define XB_SPIN(cond, bar) do { unsigned _sp = 0; while (cond) { __builtin_amdgcn_s_sleep(1); \
    if ((++_sp & 255u) == 0u) { if (xb_ld(&(bar)[XB_TMO])) break; if (_sp > XB_SPIN_CAP) { atomicAdd(&(bar)[XB_TMO], 1u); break; } } } } while (0)
struct XcdBarrier { unsigned* bar; unsigned x; volatile LAS unsigned* st; };
__device__ __forceinline__ XcdBarrier xcd_barrier_post(unsigned* bar, volatile LAS unsigned* st) {
    XcdBarrier b; b.bar = bar; b.x = xb_xcc_id(); b.st = st;
    if (threadIdx.x == 0) (void)xb_add(&bar[XB_XCNT(b.x)], 1u);
    return b;
}
__device__ __forceinline__ void xcd_barrier_complete(unsigned* bar, unsigned x, unsigned& nloc, unsigned& nx) {
    const unsigned G = gridDim.x * gridDim.y * gridDim.z;
    unsigned sum, cnt, mine, sp = 0u;
    for (;;) {
        sum = 0u; cnt = 0u; mine = 0u;
#pragma unroll
        for (unsigned j = 0; j < 16; ++j) { const unsigned c = xb_ld(&bar[XB_XCNT(j)]); sum += c; cnt += (c > 0u) ? 1u : 0u; mine = (j == x) ? c : mine; }
        if (sum == G) break;
        __builtin_amdgcn_s_sleep(1);
        if ((++sp & 255u) == 0u) { if (xb_ld(&bar[XB_TMO])) break; if (sp > XB_SPIN_CAP) { atomicAdd(&bar[XB_TMO], 1u); break; } }
    }
    nloc = mine > 0u ? mine : 1u; nx = cnt > 0u ? cnt : 1u;
}
__device__ __forceinline__ void xcd_barrier(const XcdBarrier& b, int tid0) {
    asm volatile("s_waitcnt vmcnt(0)" ::: "memory");
    __syncthreads();
    if (tid0 == 0) {
        unsigned* bar = b.bar;
        __builtin_amdgcn_s_waitcnt(0);
        unsigned nloc = b.st[0], nx = b.st[1];
        if (nloc == 0u) { xcd_barrier_complete(bar, b.x, nloc, nx); b.st[0] = nloc; b.st[1] = nx; }
        const unsigned old = xb_add(&bar[XB_XSUB(b.x)], 1u);
        const unsigned gen = old / nloc;
        if (old + 1u == (gen + 1u) * nloc) {
            __builtin_amdgcn_fence(__ATOMIC_RELEASE, "agent");
            asm volatile("s_waitcnt vmcnt(0)" ::: "memory");
            const unsigned og = xb_add(&bar[XB_TOP], 1u);
            const unsigned tg = og / nx;
            if (og + 1u == (tg + 1u) * nx) xb_add(&bar[XB_TOPGEN], 1u);
            else XB_SPIN(xb_ld(&bar[XB_TOPGEN]) == tg, bar);
            __builtin_amdgcn_fence(__ATOMIC_ACQUIRE, "agent");
            xb_add(&bar[XB_XGEN(b.x)], 1u);
            asm volatile("s_waitcnt vmcnt(0)" ::: "memory");
        } else {
            XB_SPIN(xb_ld(&bar[XB_XGEN(b.x)]) == gen, bar);
            __builtin_amdgcn_fence(__ATOMIC_ACQUIRE, "agent");
            asm volatile("s_waitcnt vmcnt(0)" ::: "memory");
        }
    }
    __syncthreads();
}

namespace pg8 {
constexpr int BM = 256, BK = 64, HALF = 128, HTB = HALF * BK * 2, STAGE_BYTES = 8 * HTB, NXCD = 8, WGM = 8;
__host__ __device__ __forceinline__ int lds_byte(int r, int c) { const int st = (r >> 4) * 2 + (c >> 5), rr = r & 15, cc = c & 31, ob = rr * 64 + cc * 2; return st * 1024 + (ob ^ (((ob >> 9) & 1) << 5)); }
__host__ __device__ __forceinline__ void stage_rc(int b, int& R, int& C) { const int st = b / 1024, sb = b % 1024, swz = sb ^ (((sb >> 9) & 1) << 5); R = (st >> 1) * 16 + swz / 64; C = (st & 1) * 32 + (swz % 64) / 2; }
__host__ __device__ __forceinline__ int perm32(int rho) { const int n = rho >> 4, i = rho & 15; return 8 * (i >> 2) + 4 * n + (i & 3); }

struct GUnit { const char* A; const char* B; char* C; int ldc; int pm, pn, z; float scale; };
struct GemmG { int lda, ldb, K; };
__device__ __forceinline__ void tile_order(int L, int nM, int nN, int& pm, int& pn) {
    const int nwg = nM * nN; int wgid = L;
    { const int q = nwg / NXCD, r = nwg % NXCD, xcd = wgid % NXCD, off = wgid / NXCD; wgid = (xcd < r ? xcd * (q + 1) : r * (q + 1) + (xcd - r) * q) + off; }
    const int nig = WGM * nN, gid = wgid / nig, fm = gid * WGM, gsz = (nM - fm) < WGM ? (nM - fm) : WGM;
    pm = fm + ((wgid % nig) % gsz); pn = (wgid % nig) / gsz;
}

__device__ __forceinline__ void glds16s(const void* sbase, unsigned voff, unsigned lds_dst) { unsigned keep;
    asm volatile("s_mov_b32 %0, m0\n\ts_mov_b32 m0, %3\n\ts_nop 2\n\tglobal_load_lds_dwordx4 %1, %2\n\ts_mov_b32 m0, %0" : "=&s"(keep) : "v"(voff), "s"(sbase), "s"(lds_dst) : "memory"); }
template <class E, class = void> struct epi_chain { static constexpr bool v = false; };
template <class E> struct epi_chain<E, decltype((void)E::CHAIN)> { static constexpr bool v = E::CHAIN; };
template <class E, class = void> struct epi_bblk { static constexpr bool v = false; };
template <class E> struct epi_bblk<E, decltype((void)E::BBLK)> { static constexpr bool v = E::BBLK; };
template <class Epi, class Sched>
__device__ __forceinline__ void gemm_phase(LAS uchar* lds, const GemmG g, const Sched& S, const Epi& E, int wave_s) {
    constexpr bool BBLK = epi_bblk<Epi>::v;
    int tid_ = wave_s * 64 + fresh_lane();
    const int tid = tid_, wid = __builtin_amdgcn_readfirstlane(tid >> 6), lane = tid & 63, wr = wid >> 2, wc = wid & 3, fr = lane & 15, fq = lane >> 4;
    const int K = g.K, nt = K / BK;
    unsigned voffA[2], voffB[2];
#pragma unroll
    for (int i = 0; i < 2; ++i) { int R, C; stage_rc(tid * 16 + i * 8192, R, C); const int Rb = Epi::PERM ? ((R & ~31) + perm32(R & 31)) : R;
        voffA[i] = (unsigned)(R * g.lda + C) * 2u; voffB[i] = BBLK ? (unsigned)((C >> 5) * g.ldb + Rb * 64 + ((C * 2) & 63)) : (unsigned)(Rb * g.ldb + C) * 2u; }
    const size_t kstep = (size_t)(BK * 2), kstepB = BBLK ? (size_t)2 * g.ldb : (size_t)(BK * 2);
    const size_t hstepA = (size_t)HALF * g.lda * 2, hstepB = BBLK ? (size_t)HALF * 64 : (size_t)HALF * g.ldb * 2;
    const unsigned ldsw = (unsigned)wid * 1024u;
    const unsigned ldsb = (unsigned)__builtin_amdgcn_readfirstlane((int)((unsigned)(size_t)lds + ldsw));
    const int aoff = lds_byte(wr * 64 + fr, fq * 8), boff = lds_byte(wc * 32 + fr, fq * 8);
#define PG8_SA(b, h) (((b) * 2 + (h)) * HTB)
#define PG8_SB(b, h) ((4 + (b) * 2 + (h)) * HTB)
#define PG8_STAGE(bufoff, gbase, voff) do { _Pragma("unroll") for (int _i = 0; _i < 2; ++_i) \
        glds16s((const void*)(gbase), (voff)[_i], ldsb + (unsigned)((bufoff) + _i * 8192)); } while (0)
#define PG8_LDA(dst, b, h) do { if constexpr (Epi::FP8) { _Pragma("unroll") for (int m = 0; m < 4; ++m) dst##8[m] = __builtin_shufflevector(*(const LAS v4i*)(lds + PG8_SA(b, h) + aoff + m * 2048), *(const LAS v4i*)(lds + PG8_SA(b, h) + aoff + m * 2048 + 1024), 0, 1, 2, 3, 4, 5, 6, 7); } \
        else { _Pragma("unroll") for (int m = 0; m < 4; ++m) _Pragma("unroll") for (int k = 0; k < 2; ++k) dst[m][k] = *(const LAS bf16x8*)(lds + PG8_SA(b, h) + aoff + m * 2048 + k * 1024); } } while (0)
#define PG8_LDB(dst, b, h) do { if constexpr (Epi::FP8) { _Pragma("unroll") for (int n = 0; n < 2; ++n) dst##8[n] = __builtin_shufflevector(*(const LAS v4i*)(lds + PG8_SB(b, h) + boff + n * 2048), *(const LAS v4i*)(lds + PG8_SB(b, h) + boff + n * 2048 + 1024), 0, 1, 2, 3, 4, 5, 6, 7); } \
        else { _Pragma("unroll") for (int n = 0; n < 2; ++n) _Pragma("unroll") for (int k = 0; k < 2; ++k) dst[n][k] = *(const LAS bf16x8*)(lds + PG8_SB(b, h) + boff + n * 2048 + k * 1024); } } while (0)
#define PG8_CAT8(x, y) __builtin_shufflevector(__builtin_bit_cast(v4i, x), __builtin_bit_cast(v4i, y), 0, 1, 2, 3, 4, 5, 6, 7)
#define PG8_MMA(ai, bj, At, Bt) do { __builtin_amdgcn_s_setprio(1); \
        if constexpr (Epi::FP8) { _Pragma("unroll") for (int m = 0; m < 4; ++m) _Pragma("unroll") for (int n = 0; n < 2; ++n) \
            acc[ai][bj][m][n] = __builtin_amdgcn_mfma_scale_f32_16x16x128_f8f6f4(Bt##8[n], At##8[m], acc[ai][bj][m][n], 0, 0, 0, 127, 0, 127); } \
        else { _Pragma("unroll") for (int m = 0; m < 4; ++m) _Pragma("unroll") for (int n = 0; n < 2; ++n) _Pragma("unroll") for (int k = 0; k < 2; ++k) \
            acc[ai][bj][m][n] = __builtin_amdgcn_mfma_f32_16x16x32_bf16(Bt[n][k], At[m][k], acc[ai][bj][m][n], 0, 0, 0); } \
        __builtin_amdgcn_s_setprio(0); } while (0)
#define PG8_WAIT_V(n) asm volatile("s_waitcnt vmcnt(" #n ")" ::: "memory")
#define PG8_WAIT_L(n) asm volatile("s_waitcnt lgkmcnt(" #n ")" ::: "memory")
#define PG8_BAR __builtin_amdgcn_s_barrier()
#define PG8_SCHED __builtin_amdgcn_sched_barrier(0)
    GUnit cur, nxt; int ui = 0;
    if (!S.next(0, cur)) return;
    f32x4 acc[2][2][4][2];
#pragma unroll
    for (int a = 0; a < 2; ++a)
#pragma unroll
        for (int b = 0; b < 2; ++b)
#pragma unroll
            for (int m = 0; m < 4; ++m)
#pragma unroll
                for (int n = 0; n < 2; ++n) acc[a][b][m][n] = (f32x4){0.f, 0.f, 0.f, 0.f};
    bf16x8 At[4][2], B0[2][2], B1[2][2]; v8i At8[4], B08[2], B18[2];
    const char* cA = cur.A; const char* cB = cur.B;
    PG8_STAGE(PG8_SB(0, 0), cB, voffB); PG8_STAGE(PG8_SB(0, 1), cB + hstepB, voffB); PG8_STAGE(PG8_SA(0, 0), cA, voffA); PG8_STAGE(PG8_SA(0, 1), cA + hstepA, voffA);
    if (wr == 1) PG8_BAR;
    PG8_WAIT_V(2); PG8_BAR;
    PG8_STAGE(PG8_SB(1, 0), cB + kstepB, voffB); PG8_STAGE(PG8_SA(1, 0), cA + kstep, voffA); PG8_STAGE(PG8_SB(1, 1), cB + hstepB + kstepB, voffB);
    PG8_WAIT_V(6); PG8_BAR;
    for (;;) {
        const bool has_next = S.next(ui + 1, nxt);
        const char* nA = has_next ? nxt.A : cA; const char* nB = has_next ? nxt.B : cB;
        for (int t = 0; t < nt; t += 2) {
            const bool last = (t == nt - 2);
            const char* a1 = cA + (size_t)(t + 1) * kstep;
            const char* a2 = last ? nA : cA + (size_t)(t + 2) * kstep; const char* b2 = last ? nB : cB + (size_t)(t + 2) * kstepB;
            const char* a3 = a2 + kstep; const char* b3 = b2 + kstepB;
            PG8_LDB(B0, 0, 0); PG8_LDB(B1, 0, 1); PG8_SCHED; PG8_LDA(At, 0, 0); PG8_STAGE(PG8_SA(1, 1), a1 + hstepA, voffA);
            PG8_WAIT_V(8); PG8_WAIT_L(0); PG8_BAR; PG8_MMA(0, 0, At, B0); PG8_MMA(0, 1, At, B1); PG8_BAR; PG8_SCHED;
            PG8_LDA(At, 0, 1); PG8_STAGE(PG8_SB(0, 0), b2, voffB); PG8_STAGE(PG8_SB(0, 1), b2 + hstepB, voffB); PG8_STAGE(PG8_SA(0, 0), a2, voffA);
            PG8_WAIT_V(8); PG8_WAIT_L(0); PG8_BAR; PG8_MMA(1, 0, At, B0); PG8_MMA(1, 1, At, B1); PG8_BAR; PG8_SCHED;
            PG8_LDB(B0, 1, 0); PG8_LDB(B1, 1, 1); PG8_SCHED; PG8_LDA(At, 1, 0); PG8_STAGE(PG8_SA(0, 1), a2 + hstepA, voffA);
            PG8_WAIT_V(8); PG8_WAIT_L(0); PG8_BAR; PG8_MMA(0, 0, At, B0); PG8_MMA(0, 1, At, B1); PG8_BAR; PG8_SCHED;
            PG8_LDA(At, 1, 1); PG8_STAGE(PG8_SB(1, 0), b3, voffB); PG8_STAGE(PG8_SB(1, 1), b3 + hstepB, voffB); PG8_STAGE(PG8_SA(1, 0), a3, voffA);
            PG8_WAIT_V(8); PG8_WAIT_L(0); PG8_BAR; PG8_MMA(1, 0, At, B0); PG8_MMA(1, 1, At, B1); PG8_BAR; PG8_SCHED;
        }
        if (wr == 0) PG8_BAR;
        E(acc, cur, wr, wc, fr, fq);
        if (!has_next) break;
        if (!epi_chain<Epi>::v || cur.z == 2) {
#pragma unroll
        for (int a = 0; a < 2; ++a)
#pragma unroll
            for (int b = 0; b < 2; ++b)
#pragma unroll
                for (int m = 0; m < 4; ++m)
#pragma unroll
                    for (int n = 0; n < 2; ++n) acc[a][b][m][n] = (f32x4){0.f, 0.f, 0.f, 0.f};
        }
        cur = nxt; cA = nA; cB = nB; ++ui;
        if (wr == 1) PG8_BAR;
    }
    PG8_WAIT_V(0);
    PG8_BAR;
#undef PG8_SA
#undef PG8_SB
#undef PG8_STAGE
#undef PG8_LDA
#undef PG8_LDB
#undef PG8_MMA
#undef PG8_CAT8
#undef PG8_WAIT_V
#undef PG8_WAIT_L
#undef PG8_BAR
#undef PG8_SCHED
}

__device__ __forceinline__ unsigned pk4_fp8(float a, float b, float c, float d) {
    a = fminf(fmaxf(a, -448.f), 448.f); b = fminf(fmaxf(b, -448.f), 448.f); c = fminf(fmaxf(c, -448.f), 448.f); d = fminf(fmaxf(d, -448.f), 448.f);
    int r = 0; r = __builtin_amdgcn_cvt_pk_fp8_f32(a, b, r, false); r = __builtin_amdgcn_cvt_pk_fp8_f32(c, d, r, true); return (unsigned)r;
}
template <bool F8> struct EpiBf16T {
    static constexpr bool FP8 = F8; static constexpr bool PERM = true;
    __device__ __forceinline__ void operator()(const f32x4 (&acc)[2][2][4][2], const GUnit& u, int wr, int wc, int fr, int fq) const {
        const int l_ = fresh_lane(); fr = l_ & 15; fq = l_ >> 4;
        bf16* base = (bf16*)u.C + (size_t)(wr * 64 + fr) * u.ldc + wc * 32 + 8 * fq; const float s = u.scale;
#pragma unroll
        for (int ai = 0; ai < 2; ++ai)
#pragma unroll
            for (int m = 0; m < 4; ++m) { bf16* rowp = base + (size_t)(ai * HALF + m * 16) * u.ldc;
#pragma unroll
                for (int bj = 0; bj < 2; ++bj) { const f32x4 v0 = acc[ai][bj][m][0] * s, v1 = acc[ai][bj][m][1] * s;
                    v4u w; w.x = cvt_pk_bf16(v0[0], v0[1]); w.y = cvt_pk_bf16(v0[2], v0[3]); w.z = cvt_pk_bf16(v1[0], v1[1]); w.w = cvt_pk_bf16(v1[2], v1[3]);
                    *(v4u*)(rowp + bj * HALF) = w; } }
    }
};
typedef EpiBf16T<false> EpiBf16;
template <bool F8> struct EpiF32T {
    static constexpr bool FP8 = F8; static constexpr bool PERM = false;
    const float* R;
    __device__ __forceinline__ void operator()(const f32x4 (&acc)[2][2][4][2], const GUnit& u, int wr, int wc, int fr, int fq) const {
        const int l_ = fresh_lane(); fr = l_ & 15; fq = l_ >> 4;
        float* base = (float*)u.C + (size_t)(wr * 64 + fr) * u.ldc + wc * 32 + 4 * fq; const float sc = u.scale;
        const float* rb = R ? R + ((size_t)u.pm * BM + wr * 64 + fr) * u.ldc + (size_t)u.pn * BM + wc * 32 + 4 * fq : nullptr;
#pragma unroll
        for (int ai = 0; ai < 2; ++ai) {
            f32x4 rv[4][2][2];
#pragma unroll
            for (int m = 0; m < 4; ++m)
#pragma unroll
                for (int bj = 0; bj < 2; ++bj)
#pragma unroll
                    for (int n = 0; n < 2; ++n) rv[m][bj][n] = rb ? *(const f32x4*)(rb + (size_t)(ai * HALF + m * 16) * u.ldc + bj * HALF + n * 16) : (f32x4){0.f, 0.f, 0.f, 0.f};
#pragma unroll
            for (int m = 0; m < 4; ++m) { const size_t ro = (size_t)(ai * HALF + m * 16) * u.ldc;
#pragma unroll
                for (int bj = 0; bj < 2; ++bj)
#pragma unroll
                    for (int n = 0; n < 2; ++n) *(f32x4*)(base + ro + bj * HALF + n * 16) = acc[ai][bj][m][n] * sc + rv[m][bj][n]; } }
    }
};
typedef EpiF32T<false> EpiF32;
struct EpiOutFp8 {
    static constexpr bool FP8 = false; static constexpr bool PERM = true;
    __device__ __forceinline__ void operator()(const f32x4 (&acc)[2][2][4][2], const GUnit& u, int wr, int wc, int fr, int fq) const {
        const int l_ = fresh_lane(); fr = l_ & 15; fq = l_ >> 4;
        uchar* base = (uchar*)u.C + (size_t)(wr * 64 + fr) * u.ldc + wc * 32 + 8 * fq; const float s = u.scale;
#pragma unroll
        for (int ai = 0; ai < 2; ++ai)
#pragma unroll
            for (int m = 0; m < 4; ++m) { uchar* rowp = base + (size_t)(ai * HALF + m * 16) * u.ldc;
#pragma unroll
                for (int bj = 0; bj < 2; ++bj) { const f32x4 v0 = acc[ai][bj][m][0] * s, v1 = acc[ai][bj][m][1] * s;
                    v2u w; w.x = pk4_fp8(v0[0], v0[1], v0[2], v0[3]); w.y = pk4_fp8(v1[0], v1[1], v1[2], v1[3]); *(v2u*)(rowp + bj * HALF) = w; } }
    }
};
struct EpiMerge {
    static constexpr bool FP8 = true; static constexpr bool PERM = true; static constexpr bool CHAIN = true;
    const bf16* gate; uchar* mix8;
    __device__ __forceinline__ void operator()(f32x4 (&acc)[2][2][4][2], const GUnit& u, int wr, int wc, int fr, int fq) const {
        const int l_ = fresh_lane(); fr = l_ & 15; fq = l_ >> 4;
        const size_t row0 = (size_t)u.pm * BM + wr * 64 + fr; const int col0 = u.pn * BM + wc * 32 + 8 * fq; const int z = u.z;
        const bool fin = z == 2; const float f0 = z == 0 ? 2.f : 1.f, f2 = u.scale * 32.f; const size_t zb = fin ? (size_t)2 * 4096 : (size_t)(z + 1) * 4096;
#pragma unroll
        for (int aq = 0; aq < 4; ++aq) { const int ai = aq >> 1, m0 = (aq & 1) * 2;
            asm volatile("" ::: "memory");
            v4u ga[4][2], gb[4][2];
#pragma unroll
            for (int m = m0; m < m0 + 2; ++m)
#pragma unroll
                for (int bj = 0; bj < 2; ++bj) { const size_t row = row0 + ai * HALF + m * 16; const int col = col0 + bj * HALF;
                    ga[m][bj] = *(const v4u*)(gate + row * 12288 + (size_t)z * 4096 + col); gb[m][bj] = *(const v4u*)(gate + row * 12288 + zb + col); }
#pragma unroll
            for (int m = m0; m < m0 + 2; ++m)
#pragma unroll
                for (int bj = 0; bj < 2; ++bj) { const v4u a4 = ga[m][bj], b4 = gb[m][bj];
                    const float gl[8] = {bflo(a4.x), bfhi(a4.x), bflo(a4.y), bfhi(a4.y), bflo(a4.z), bfhi(a4.z), bflo(a4.w), bfhi(a4.w)};
                    const float gn[8] = {bflo(b4.x), bfhi(b4.x), bflo(b4.y), bfhi(b4.y), bflo(b4.z), bfhi(b4.z), bflo(b4.w), bfhi(b4.w)};
#pragma unroll
                    for (int j = 0; j < 8; ++j) { const float a0 = __expf(-fminf(fmaxf(gl[j], -30.f), 30.f)), a1 = __expf(-fminf(fmaxf(gn[j], -30.f), 30.f));
                        acc[ai][bj][m][j >> 2][j & 3] *= (fin ? f2 : f0 * (1.0f + a1)) * __builtin_amdgcn_rcpf(1.0f + a0); } }
        }
        if (fin) {
#pragma unroll
            for (int ai = 0; ai < 2; ++ai)
#pragma unroll
                for (int m = 0; m < 4; ++m)
#pragma unroll
                    for (int bj = 0; bj < 2; ++bj) { const size_t row = row0 + ai * HALF + m * 16; const int col = col0 + bj * HALF; const f32x4 v0 = acc[ai][bj][m][0], v1 = acc[ai][bj][m][1];
                        v2u w; w.x = pk4_fp8(v0[0], v0[1], v0[2], v0[3]); w.y = pk4_fp8(v1[0], v1[1], v1[2], v1[3]);
                        *(v2u*)(mix8 + row * 4096 + col) = w; }
        }
    }
};

__device__ __forceinline__ f32x2 gelu_pk(f32x2 v) {
    const f32x2 av = __builtin_elementwise_abs(v), d = av * 0.2316418882f + 1.0f;
    f32x2 t; t.x = __builtin_amdgcn_rcpf(d.x); t.y = __builtin_amdgcn_rcpf(d.y);
    f32x2 q = t * 0.5307027145f + (-0.7265760135f); q = q * t + 0.7107068705f; q = q * t + (-0.142248368f); q = q * t + 0.127414796f; q = q * t;
    const f32x2 s = (v * v) * (-0.72134752044f);
    f32x2 e; e.x = __builtin_amdgcn_exp2f(s.x); e.y = __builtin_amdgcn_exp2f(s.y);
    const f32x2 m = v * (q * e), r = v - m;
    f32x2 o; o.x = v.x < 0.f ? m.x : r.x; o.y = v.y < 0.f ? m.y : r.y; return o;
}
struct EpiPeerA8 {
    static constexpr bool FP8 = true; static constexpr bool PERM = true;
    const uchar* g; uchar* a8;
    __device__ __forceinline__ void operator()(const f32x4 (&acc)[2][2][4][2], const GUnit& u, int wr, int wc, int fr, int fq) const {
        const int l_ = fresh_lane(); fr = l_ & 15; fq = l_ >> 4;
        const size_t row0 = (size_t)u.pm * BM + wr * 64 + fr; const int col0 = u.pn * BM + wc * 32 + 8 * fq;
        v2u gws[2][4][2];
#pragma unroll
        for (int ai = 0; ai < 2; ++ai)
#pragma unroll
            for (int m = 0; m < 4; ++m)
#pragma unroll
                for (int bj = 0; bj < 2; ++bj) gws[ai][m][bj] = *(const v2u*)(g + (row0 + ai * HALF + m * 16) * 16384 + col0 + bj * HALF);
#pragma unroll
        for (int ai = 0; ai < 2; ++ai)
#pragma unroll
            for (int m = 0; m < 4; ++m) { const size_t row = row0 + ai * HALF + m * 16;
#pragma unroll
                for (int bj = 0; bj < 2; ++bj) { const size_t off = row * 16384 + col0 + bj * HALF;
                    const v2u gw = gws[ai][m][bj]; v2u w = {0u, 0u};
                    if ((gw.x | gw.y) != 0u) {
                        const f32x4 v0 = acc[ai][bj][m][0] * 0.000244140625f, v1 = acc[ai][bj][m][1] * 0.000244140625f;
                        const f32x2 a = gelu_pk((f32x2){v0[0], v0[1]}), b = gelu_pk((f32x2){v0[2], v0[3]}), c = gelu_pk((f32x2){v1[0], v1[1]}), d = gelu_pk((f32x2){v1[2], v1[3]});
                        const f32x2 g0 = __builtin_amdgcn_cvt_pk_f32_fp8((int)gw.x, false), g1 = __builtin_amdgcn_cvt_pk_f32_fp8((int)gw.x, true), g2 = __builtin_amdgcn_cvt_pk_f32_fp8((int)gw.y, false), g3 = __builtin_amdgcn_cvt_pk_f32_fp8((int)gw.y, true);
                        w.x = pk4_fp8(a.x * g0.x, a.y * g0.y, b.x * g1.x, b.y * g1.y);
                        w.y = pk4_fp8(c.x * g2.x, c.y * g2.y, d.x * g3.x, d.y * g3.y); }
                    *(v2u*)(a8 + off) = w; } }
    }
};
}

struct Ptrs {
    const float* in[23]; float* out; uchar* ws;
};
struct SchedP1 {
    uchar* ws; int G, c; bool f8;
    __device__ __forceinline__ bool next(int i, pg8::GUnit& u) const {
        const int L = i * G + c; const int nN = f8 ? 133 - P1_NB16 : P1_NB16; const int NREG = 64 * nN;
        if (L >= NREG + (f8 ? 64 : 0)) return false;
        const size_t ESZ = f8 ? 1 : 2; const float S0 = f8 ? 0.000244140625f : 1.f;
        u.scale = S0; u.z = 0;
        if (L < NREG) {
            int pm, pn; pg8::tile_order(L, 64, nN, pm, pn); if (f8) pn += P1_NB16; u.pm = pm; u.pn = pn;
            u.A = (const char*)(ws + (f8 ? WS_XN8 : WS_XN)) + (size_t)pm * 256 * D * ESZ; u.B = (const char*)(ws + (f8 ? WS_WIN8 : WS_WIN_T)) + (size_t)pn * 256 * D * ESZ;
            size_t base; int ldc, ct;
            if (pn < 8) { base = WS_GQ; ldc = 2048; ct = pn; u.scale = 0.0625f * S0; }
            else if (pn < 24) { base = WS_GR; ldc = 4096; ct = pn - 8; }
            else if (pn < 32) { base = WS_GK; ldc = 2048; ct = pn - 24; }
            else if (pn < 48) { base = WS_GV; ldc = 4096; ct = pn - 32; }
            else if (pn < 64) { base = WS_SQ; ldc = 4096; ct = pn - 48; }
            else if (pn < 66) { base = WS_SK; ldc = 512; ct = pn - 64; }
            else if (pn < 68) { base = WS_SV; ldc = 512; ct = pn - 66; }
            else if (pn < 84) { base = WS_MQ; ldc = 4096; ct = pn - 68; }
            else if (pn < 132) { base = WS_GATE; ldc = 12288; ct = pn - 84; }
            else { base = WS_GLRP; ldc = 256; ct = 0; }
            u.ldc = ldc; u.C = (char*)(ws + base) + ((size_t)pm * 256 * ldc + (size_t)ct * 256) * 2;
        } else {
            const int j = L - NREG, pm = j >> 5, pn = j & 31; u.pm = pm; u.pn = pn; u.z = 1;
            u.A = (const char*)(ws + WS_MEMN) + (size_t)pm * 256 * D; u.B = (const char*)(ws + WS_WKV_T) + (size_t)pn * 256 * D;
            u.ldc = 8192; u.C = (char*)(ws + WS_KVM) + ((size_t)pm * 256 * 8192 + (size_t)pn * 256) * 2;
        }
        return true;
    }
};
struct SchedMerge {
    uchar* ws; int G, c;
    __device__ __forceinline__ bool next(int i, pg8::GUnit& u) const {
        const int r = i / 3, z = i - 3 * r, L = r * G + c;
        if (L >= 64 * 16) return false;
        int pm, pn; pg8::tile_order(L, 64, 16, pm, pn); u.pm = pm; u.pn = pn; u.z = z; u.ldc = 4096; u.C = nullptr;
        u.scale = z == 0 ? 0.0001220703125f : 0.00006103515625f;
        const size_t ab = z == 0 ? WS_OA8 : (z == 1 ? WS_OB8 : WS_OC8);
        u.A = (const char*)(ws + ab) + (size_t)pm * 256 * D; u.B = (const char*)(ws + WS_WBR_T) + ((size_t)z * 4096 + (size_t)pn * 256) * D;
        return true;
    }
};
struct SchedPlain {
    const char* A; const char* B; char* C; int nM, nN, K, esz, G, c; float scale;
    __device__ __forceinline__ bool next(int i, pg8::GUnit& u) const {
        const int L = i * G + c; if (L >= nM * nN) return false;
        int pm, pn; pg8::tile_order(L, nM, nN, pm, pn); u.pm = pm; u.pn = pn; u.z = 0; u.scale = scale; u.ldc = nN * 256;
        u.A = A + (size_t)pm * 256 * K * 2; u.B = B + (size_t)pn * 256 * K * 2; u.C = C + ((size_t)pm * 256 * u.ldc + (size_t)pn * 256) * esz;
        return true;
    }
};

struct EpiWoutHB {
    static constexpr bool FP8 = true; static constexpr bool PERM = true;
    const float* X; bf16* HB;
    __device__ __forceinline__ void operator()(const f32x4 (&acc)[2][2][4][2], const pg8::GUnit& u, int wr, int wc, int fr, int fq) const {
        constexpr int HALF = pg8::HALF;
        const int l_ = fresh_lane(); fr = l_ & 15; fq = l_ >> 4;
        const size_t e0 = ((size_t)u.pm * 256 + wr * 64 + fr) * 4096 + (size_t)u.pn * 256 + wc * 32 + 8 * fq; const float sc = u.scale;
#pragma unroll
        for (int ai = 0; ai < 2; ++ai) {
            f32x4 rv[4][2][2];
#pragma unroll
            for (int m = 0; m < 4; ++m)
#pragma unroll
                for (int bj = 0; bj < 2; ++bj)
#pragma unroll
                    for (int n = 0; n < 2; ++n) rv[m][bj][n] = *(const f32x4*)(X + e0 + (size_t)(ai * HALF + m * 16) * 4096 + bj * HALF + n * 4);
#pragma unroll
            for (int m = 0; m < 4; ++m)
#pragma unroll
                for (int bj = 0; bj < 2; ++bj) { const f32x4 v0 = acc[ai][bj][m][0] * sc + rv[m][bj][0], v1 = acc[ai][bj][m][1] * sc + rv[m][bj][1];
                    v4u w; w.x = pk2(v0[0], v0[1]); w.y = pk2(v0[2], v0[3]); w.z = pk2(v1[0], v1[1]); w.w = pk2(v1[2], v1[3]);
                    *(v4u*)(HB + e0 + (size_t)(ai * HALF + m * 16) * 4096 + bj * HALF) = w; } }
    }
};
struct EpiPeer2 {
    static constexpr bool FP8 = true; static constexpr bool PERM = true; static constexpr bool BBLK = true;
    const bf16* HB; float* O;
    __device__ __forceinline__ void operator()(const f32x4 (&acc)[2][2][4][2], const pg8::GUnit& u, int wr, int wc, int fr, int fq) const {
        constexpr int HALF = pg8::HALF;
        const int l_ = fresh_lane(); fr = l_ & 15; fq = l_ >> 4;
        const size_t e0 = ((size_t)u.pm * 256 + wr * 64 + fr) * 4096 + (size_t)u.pn * 256 + wc * 32 + 8 * fq; const float sc = u.scale;
#pragma unroll
        for (int ai = 0; ai < 2; ++ai) {
            v4u rv[4][2];
#pragma unroll
            for (int m = 0; m < 4; ++m)
#pragma unroll
                for (int bj = 0; bj < 2; ++bj) rv[m][bj] = *(const v4u*)(HB + e0 + (size_t)(ai * HALF + m * 16) * 4096 + bj * HALF);
#pragma unroll
            for (int m = 0; m < 4; ++m)
#pragma unroll
                for (int bj = 0; bj < 2; ++bj) { const v4u r_ = rv[m][bj]; float* op = O + e0 + (size_t)(ai * HALF + m * 16) * 4096 + bj * HALF;
                    f32x4 v0 = acc[ai][bj][m][0] * sc, v1 = acc[ai][bj][m][1] * sc;
                    v0[0] += bflo(r_.x); v0[1] += bfhi(r_.x); v0[2] += bflo(r_.y); v0[3] += bfhi(r_.y); v1[0] += bflo(r_.z); v1[1] += bfhi(r_.z); v1[2] += bflo(r_.w); v1[3] += bfhi(r_.w);
                    *(f32x4*)op = v0; *(f32x4*)(op + 4) = v1; } }
    }
};
struct SchedPeer2 {
    const char* A; const char* B; char* C; int G, c; float scale;
    __device__ __forceinline__ bool next(int i, pg8::GUnit& u) const {
        const int L = i * G + c; if (L >= 64 * 16) return false;
        int pm, pn; pg8::tile_order(L, 64, 16, pm, pn); u.pm = pm; u.pn = pn; u.z = 0; u.scale = scale; u.ldc = 4096;
        u.A = A + (size_t)pm * 256 * 16384; u.B = B + (size_t)pn * 256 * 64; u.C = C + ((size_t)pm * 256 * 4096 + (size_t)pn * 256) * 4;
        return true;
    }
};

struct SchedMemS {
    uchar* ws; int G, c;
    __device__ __forceinline__ bool next(int i, pg8::GUnit& u) const {
        const int L = i * G + c; if (L >= 256) return false;
        const int pm = L >> 2, h = L & 3, b = pm >> 5; u.pm = pm; u.pn = 0; u.z = h; u.scale = 1.f; u.ldc = 0; u.C = nullptr;
        u.A = (const char*)(ws + WS_MQ) + ((size_t)pm * 256 * 4096 + (size_t)h * 1024) * 2; u.B = (const char*)(ws + WS_KVM) + ((size_t)b * 256 * 8192 + (size_t)h * 1024) * 2;
        return true;
    }
};
struct SchedMemO {
    uchar* ws; int G, c;
    __device__ __forceinline__ bool next(int i, pg8::GUnit& u) const {
        const int L = i * G + c; if (L >= 1024) return false;
        const int pm = L >> 4, h = (L >> 2) & 3, pn = L & 3, b = pm >> 5; u.pm = pm; u.pn = pn; u.z = h; u.scale = 32.f; u.ldc = 4096;
        u.A = (const char*)(ws + WS_PM) + ((size_t)pm * 256 * 1024 + (size_t)h * 256) * 2; u.B = (const char*)(ws + WS_VTM) + ((size_t)(b * 4096 + h * 1024 + pn * 256) * 256) * 2;
        u.C = (char*)(ws + WS_OC8) + ((size_t)pm * 256 * 4096 + (size_t)h * 1024 + (size_t)pn * 256);
        return true;
    }
};
namespace pg8 {
struct EpiMemS {
    static constexpr bool FP8 = false; static constexpr bool PERM = true;
    const float* rq; bf16* pmat; LAS float* part;
    __device__ __forceinline__ void operator()(f32x4 (&acc)[2][2][4][2], const GUnit& u, int wr, int wc, int fr, int fq) const {
        const int h = u.z;
#pragma unroll
        for (int ai = 0; ai < 2; ++ai)
#pragma unroll
            for (int m = 0; m < 4; ++m) { const int row = ai * HALF + wr * 64 + m * 16 + fr; const float sc = rq[((size_t)u.pm * BM + row) * 4 + h] * 1.44269504f; float s = 0.f;
#pragma unroll
                for (int bj = 0; bj < 2; ++bj)
#pragma unroll
                    for (int n = 0; n < 2; ++n) { f32x4 v = acc[ai][bj][m][n] * sc;
#pragma unroll
                        for (int j = 0; j < 4; ++j) { v[j] = __builtin_amdgcn_exp2f(v[j]); s += v[j]; }
                        acc[ai][bj][m][n] = v; }
                s += __shfl_xor(s, 16); s += __shfl_xor(s, 32);
                if (fq == 0) part[row * 4 + wc] = s; }
        asm volatile("s_waitcnt lgkmcnt(0)" ::: "memory"); __builtin_amdgcn_s_barrier(); asm volatile("" ::: "memory");
#pragma unroll
        for (int ai = 0; ai < 2; ++ai)
#pragma unroll
            for (int m = 0; m < 4; ++m) { int row = ai * HALF + wr * 64 + m * 16 + fr; asm volatile("" : "+v"(row)); const f32x4 pp = *(const LAS f32x4*)(part + row * 4); const float inv = 1.0f / ((pp.x + pp.y) + (pp.z + pp.w));
                bf16* rowp = pmat + ((size_t)u.pm * BM + row) * 1024 + h * 256 + wc * 32 + 8 * fq;
#pragma unroll
                for (int bj = 0; bj < 2; ++bj) { const f32x4 v0 = acc[ai][bj][m][0] * inv, v1 = acc[ai][bj][m][1] * inv;
                    v4u w; w.x = cvt_pk_bf16(v0[0], v0[1]); w.y = cvt_pk_bf16(v0[2], v0[3]); w.z = cvt_pk_bf16(v1[0], v1[1]); w.w = cvt_pk_bf16(v1[2], v1[3]);
                    *(v4u*)(rowp + bj * HALF) = w; } }
        asm volatile("s_waitcnt lgkmcnt(0)" ::: "memory"); __builtin_amdgcn_s_barrier(); asm volatile("" ::: "memory");
    }
};
}

constexpr int SWA_KP = 144, SWA_VP = 528;
constexpr int SWA_KOFF = 0, SWA_VOFF = 256 * SWA_KP;
__device__ __forceinline__ void swa_unit(LAS uchar* lds, const bf16* sq, const bf16* sk, const bf16* sv, uchar* ob8, const float* gq, const float* gk, const float* sinks, int b, int blk, int kvh, int tid) {
    const int lane = tid & 63, wave = __builtin_amdgcn_readfirstlane(tid >> 6);
    const long tq0 = (long)b * SEQ + (long)blk * 128, tk0 = tq0 - 128;
#pragma unroll
    for (int r = 0; r < 4; ++r) {
        const int idx = tid + 512 * r, key = idx >> 3, ch = idx & 7;
        v4u kw = {0u, 0u, 0u, 0u}, vw = {0u, 0u, 0u, 0u};
        if (blk > 0 || key >= 128) { kw = *(const GAS v4u*)(sk + (tk0 + key) * 512 + kvh * 64 + ch * 8); vw = *(const GAS v4u*)(sv + (tk0 + key) * 512 + kvh * 64 + ch * 8); }
        float kf[8] = {bflo(kw.x), bfhi(kw.x), bflo(kw.y), bfhi(kw.y), bflo(kw.z), bfhi(kw.z), bflo(kw.w), bfhi(kw.w)};
        float ss = 0.f;
#pragma unroll
        for (int i = 0; i < 8; ++i) ss += kf[i] * kf[i];
        ss += __shfl_xor(ss, 1); ss += __shfl_xor(ss, 2); ss += __shfl_xor(ss, 4);
        const float rr = rsqrtf(ss * (1.f / 64.f) + EPS);
        const f32x4 g0 = *(const GAS f32x4*)(gk + ch * 8), g1 = *(const GAS f32x4*)(gk + ch * 8 + 4);
        v4u o; o.x = pk2(kf[0] * rr * g0.x, kf[1] * rr * g0.y); o.y = pk2(kf[2] * rr * g0.z, kf[3] * rr * g0.w); o.z = pk2(kf[4] * rr * g1.x, kf[5] * rr * g1.y); o.w = pk2(kf[6] * rr * g1.z, kf[7] * rr * g1.w);
        *(LAS v4u*)(lds + SWA_KOFF + key * SWA_KP + ch * 16) = o;
        const unsigned vv[4] = {vw.x, vw.y, vw.z, vw.w};
#pragma unroll
        for (int i = 0; i < 4; ++i) { *(LAS unsigned short*)(lds + SWA_VOFF + (ch * 8 + 2 * i) * SWA_VP + key * 2) = (unsigned short)(vv[i] & 0xffffu);
                                      *(LAS unsigned short*)(lds + SWA_VOFF + (ch * 8 + 2 * i + 1) * SWA_VP + key * 2) = (unsigned short)(vv[i] >> 16); }
    }
    LDS_WAIT(); __syncthreads();
    const int g = wave, hq = kvh * 8 + g, r16 = lane & 15, g4 = lane >> 4;
    const float sink = sinks[hq];
    const f32x4 gqa = *(const GAS f32x4*)(gq + 8 * g4), gqb = *(const GAS f32x4*)(gq + 8 * g4 + 4), gqc = *(const GAS f32x4*)(gq + 32 + 8 * g4), gqd = *(const GAS f32x4*)(gq + 32 + 8 * g4 + 4);
    for (int ti = 0; ti < 8; ++ti) {
        const bf16* qp = sq + (tq0 + 16 * ti + r16) * 4096 + hq * 64;
        const v4u q0 = *(const GAS v4u*)(qp + 8 * g4), q1 = *(const GAS v4u*)(qp + 32 + 8 * g4);
        float qa[8] = {bflo(q0.x), bfhi(q0.x), bflo(q0.y), bfhi(q0.y), bflo(q0.z), bfhi(q0.z), bflo(q0.w), bfhi(q0.w)};
        float qb[8] = {bflo(q1.x), bfhi(q1.x), bflo(q1.y), bfhi(q1.y), bflo(q1.z), bfhi(q1.z), bflo(q1.w), bfhi(q1.w)};
        float ss = 0.f;
#pragma unroll
        for (int i = 0; i < 8; ++i) ss += qa[i] * qa[i] + qb[i] * qb[i];
        ss += __shfl_xor(ss, 16); ss += __shfl_xor(ss, 32);
        const float rq = rsqrtf(ss * (1.f / 64.f) + EPS) * 0.125f;
        v4u qw0, qw1;
        qw0.x = pk2(qa[0] * rq * gqa.x, qa[1] * rq * gqa.y); qw0.y = pk2(qa[2] * rq * gqa.z, qa[3] * rq * gqa.w); qw0.z = pk2(qa[4] * rq * gqb.x, qa[5] * rq * gqb.y); qw0.w = pk2(qa[6] * rq * gqb.z, qa[7] * rq * gqb.w);
        qw1.x = pk2(qb[0] * rq * gqc.x, qb[1] * rq * gqc.y); qw1.y = pk2(qb[2] * rq * gqc.z, qb[3] * rq * gqc.w); qw1.z = pk2(qb[4] * rq * gqd.x, qb[5] * rq * gqd.y); qw1.w = pk2(qb[6] * rq * gqd.z, qb[7] * rq * gqd.w);
        const bf16x8 qf0 = __builtin_bit_cast(bf16x8, qw0), qf1 = __builtin_bit_cast(bf16x8, qw1);
        f32x4 st[9];
#pragma unroll
        for (int c = 0; c < 9; ++c) {
            const LAS uchar* kp = lds + SWA_KOFF + (16 * (ti + c) + r16) * SWA_KP + 16 * g4;
            const bf16x8 k0 = *(const LAS bf16x8*)kp, k1 = *(const LAS bf16x8*)(kp + 64);
            f32x4 a = {0.f, 0.f, 0.f, 0.f};
            a = __builtin_amdgcn_mfma_f32_16x16x32_bf16(k0, qf0, a, 0, 0, 0);
            a = __builtin_amdgcn_mfma_f32_16x16x32_bf16(k1, qf1, a, 0, 0, 0);
            st[c] = a;
        }
        float mx = -INFINITY;
#pragma unroll
        for (int c = 0; c < 9; ++c)
#pragma unroll
            for (int i = 0; i < 4; ++i) { const int dlt = 16 * c + 4 * g4 + i - r16; const bool ok = (dlt >= 1) && (dlt <= 128) && (blk > 0 || (16 * (ti + c) + 4 * g4 + i) >= 128);
                st[c][i] = ok ? st[c][i] : -INFINITY; mx = fmaxf(mx, st[c][i]); }
        mx = fmaxf(mx, __shfl_xor(mx, 16)); mx = fmaxf(mx, __shfl_xor(mx, 32)); mx = fmaxf(mx, sink);
        float sum = 0.f;
#pragma unroll
        for (int c = 0; c < 9; ++c)
#pragma unroll
            for (int i = 0; i < 4; ++i) { const float p = __expf(st[c][i] - mx); st[c][i] = p; sum += p; }
        sum += __shfl_xor(sum, 16); sum += __shfl_xor(sum, 32);
        const float inv = 1.0f / (sum + __expf(sink - mx));
        f32x4 ot[4];
#pragma unroll
        for (int dt = 0; dt < 4; ++dt) ot[dt] = (f32x4){0.f, 0.f, 0.f, 0.f};
#pragma unroll
        for (int kk = 0; kk < 5; ++kk) {
            v4u pw; pw.x = pk2(st[2 * kk][0] * inv, st[2 * kk][1] * inv); pw.y = pk2(st[2 * kk][2] * inv, st[2 * kk][3] * inv);
            if (kk < 4) { pw.z = pk2(st[2 * kk + 1][0] * inv, st[2 * kk + 1][1] * inv); pw.w = pk2(st[2 * kk + 1][2] * inv, st[2 * kk + 1][3] * inv); } else { pw.z = 0u; pw.w = 0u; }
            const bf16x8 pf = __builtin_bit_cast(bf16x8, pw);
            const int t0 = ti + 2 * kk, t1 = (ti + 2 * kk + 1) > 15 ? 15 : (ti + 2 * kk + 1);
#pragma unroll
            for (int dt = 0; dt < 4; ++dt) {
                const LAS uchar* vp = lds + SWA_VOFF + (16 * dt + r16) * SWA_VP + 8 * g4;
                const v2u va = *(const LAS v2u*)(vp + 32 * t0), vb = *(const LAS v2u*)(vp + 32 * t1);
                v4u vw; vw.x = va.x; vw.y = va.y; vw.z = vb.x; vw.w = vb.y;
                ot[dt] = __builtin_amdgcn_mfma_f32_16x16x32_bf16(__builtin_bit_cast(bf16x8, vw), pf, ot[dt], 0, 0, 0);
            }
        }
#pragma unroll
        for (int dt = 0; dt < 4; ++dt) *(GAS unsigned*)(ob8 + (tq0 + 16 * ti + r16) * 4096 + hq * 64 + 16 * dt + 4 * g4) = pg8::pk4_fp8(32.f * ot[dt][0], 32.f * ot[dt][1], 32.f * ot[dt][2], 32.f * ot[dt][3]);
    }
    __syncthreads();
}

__device__ __forceinline__ void gla_prep_item(LAS uchar* lds, uchar* ws, const float* wup, const float* bias, int it, int tid) {
    const int h = it & 7; const long t0 = (long)(it >> 3) * 64;
    const int d = tid & 255, half = tid >> 8, lane = tid & 63, wave = __builtin_amdgcn_readfirstlane(tid >> 6), r16 = lane & 15, g4 = lane >> 4;
    LAS float* glr_s = (LAS float*)lds; LAS float* tot_s = (LAS float*)(lds + 4096); LAS float* bl_s = (LAS float*)(lds + 5120);
    LAS uchar* Qs = lds + 8192; LAS uchar* Ks = Qs + 33792; LAS uchar* Kd = Ks + 33792;
    const bf16* gq = (const bf16*)(ws + WS_GQ); const bf16* gk = (const bf16*)(ws + WS_GK); const bf16* glrp = (const bf16*)(ws + WS_GLRP);
#pragma unroll
    for (int r = 0; r < 4; ++r) { const int ch = tid + 512 * r, row = ch >> 5, c8 = ch & 31; const size_t go = (size_t)(t0 + row) * 2048 + h * 256 + c8 * 8;
        *(LAS v4u*)(Qs + row * 528 + c8 * 16) = *(const GAS v4u*)(gq + go); *(LAS v4u*)(Ks + row * 528 + c8 * 16) = *(const GAS v4u*)(gk + go); }
#pragma unroll
    for (int r = 0; r < 2; ++r) { const int idx = tid + 512 * r; glr_s[idx] = bf2f(glrp[(t0 + (idx >> 4)) * 256 + (idx & 15)]); }
    float wu[16];
#pragma unroll
    for (int r = 0; r < 16; ++r) wu[r] = wup[r * 2048 + h * 256 + d];
    const float bs = bias[h * 256 + d];
    LDS_WAIT(); __syncthreads();
    float bc[32]; float run = 0.f;
#pragma unroll
    for (int ii = 0; ii < 32; ++ii) { const int i = 32 * half + ii; float s = bs;
#pragma unroll
        for (int r4 = 0; r4 < 4; ++r4) { const f32x4 gv = *(const LAS f32x4*)(glr_s + i * 16 + 4 * r4); s += gv.x * wu[4 * r4] + gv.y * wu[4 * r4 + 1] + gv.z * wu[4 * r4 + 2] + gv.w * wu[4 * r4 + 3]; }
        const float ls = (fminf(s, 0.f) - __logf(1.0f + __expf(-fabsf(s)))) * 0.0625f; run += ls; bc[ii] = run; }
    if (half == 0) tot_s[d] = run;
    LDS_WAIT(); __syncthreads();
    const float off = half ? tot_s[d] : 0.f;
    if (half == 1) bl_s[d] = run + off;
    LDS_WAIT(); __syncthreads();
    const float bl = bl_s[d]; const float gam = __expf(bl);
#pragma unroll 8
    for (int ii = 0; ii < 32; ++ii) { const int i = 32 * half + ii; const float b = bc[ii] + off; const float E = __expf(b), Ei = __builtin_amdgcn_rcpf(E), Ed = gam * Ei;
        LAS unsigned short* qp_ = (LAS unsigned short*)(Qs + i * 528 + d * 2); LAS unsigned short* kp_ = (LAS unsigned short*)(Ks + i * 528 + d * 2);
        const float q = bf2f(*qp_), k = bf2f(*kp_);
        *qp_ = (unsigned short)f2bf(q * E); *kp_ = (unsigned short)f2bf(k * Ei); *(LAS unsigned short*)(Kd + i * 528 + d * 2) = (unsigned short)f2bf(k * Ed); }
    if (half == 0) ((float*)(ws + WS_GAM))[(size_t)it * 256 + d] = gam;
    LDS_WAIT(); __syncthreads();
#pragma unroll
    for (int r = 0; r < 4; ++r) { const int ch = tid + 512 * r, fl = ch & 63, fr_ = fl & 15, fg = fl >> 4, ks = (ch >> 6) & 7, tt = ch >> 9;
        *(GAS v4u*)((bf16*)(ws + WS_QT) + (size_t)it * 16384 + (size_t)ch * 8) = *(const LAS v4u*)(Qs + (16 * tt + fr_) * 528 + (32 * ks + 8 * fg) * 2); }
#pragma unroll
    for (int r = 0; r < 4; ++r) { const int ch = tid + 512 * r, fl = ch & 63, fr_ = fl & 15, fg = fl >> 4, ks = (ch >> 6) & 1, tt = ch >> 7;
        const LAS uchar* kp_ = Kd + (32 * ks + 8 * fg) * 528 + (16 * tt + fr_) * 2; unsigned short x_[8];
#pragma unroll
        for (int jj = 0; jj < 8; ++jj) x_[jj] = *(const LAS unsigned short*)(kp_ + jj * 528);
        v4u w_; w_.x = x_[0] | ((unsigned)x_[1] << 16); w_.y = x_[2] | ((unsigned)x_[3] << 16); w_.z = x_[4] | ((unsigned)x_[5] << 16); w_.w = x_[6] | ((unsigned)x_[7] << 16);
        *(GAS v4u*)((bf16*)(ws + WS_KD) + (size_t)it * 16384 + (size_t)ch * 8) = w_; }
    const int ti = wave >> 1;
    LAS uchar* Ps = Kd + 33792;
#pragma unroll
    for (int tjj = 0; tjj < 2; ++tjj) { const int tj = 2 * (wave & 1) + tjj; f32x4 acc = {0.f, 0.f, 0.f, 0.f};
        if (tj <= ti) {
#pragma unroll
            for (int ks = 0; ks < 8; ++ks) { const bf16x8 a = *(const LAS bf16x8*)(Qs + (16 * ti + r16) * 528 + (32 * ks + 8 * g4) * 2), bb = *(const LAS bf16x8*)(Ks + (16 * tj + r16) * 528 + (32 * ks + 8 * g4) * 2);
                acc = __builtin_amdgcn_mfma_f32_16x16x32_bf16(a, bb, acc, 0, 0, 0); } }
#pragma unroll
        for (int ii = 0; ii < 4; ++ii) { const int i = 16 * ti + 4 * g4 + ii, j = 16 * tj + r16; *(LAS unsigned short*)(Ps + i * 144 + j * 2) = (unsigned short)f2bf(j <= i ? acc[ii] : 0.f); } }
    LDS_WAIT(); __syncthreads();
    { const int ch = tid, fl = ch & 63, fr_ = fl & 15, fg = fl >> 4, ks = (ch >> 6) & 1, tt = ch >> 7;
      *(GAS v4u*)((bf16*)(ws + WS_PC) + (size_t)it * 4096 + (size_t)ch * 8) = *(const LAS v4u*)(Ps + (16 * tt + fr_) * 144 + (32 * ks + 8 * fg) * 2); }
    __syncthreads();
}
__device__ __forceinline__ void gla_scan_unit(LAS uchar* lds, uchar* ws, int u, int tid) {
    const int bh = u >> 4, sl = u & 15, b = bh >> 3, h = bh & 7;
    const int lane = tid & 63, wave = __builtin_amdgcn_readfirstlane(tid >> 6), r16 = lane & 15, g4 = lane >> 4;
    LAS uchar* Sb = lds; LAS uchar* VT = lds + 2 * 16896;
    for (int i = tid; i < 16896 / 16; i += NTHR) *(LAS v4u*)(Sb + i * 16) = (v4u){0u, 0u, 0u, 0u};
    const long it0 = ((long)b * 128) * 8 + h, tb = (long)b * SEQ;
    constexpr int UN = 8;
    if (wave < 4) {
        const int ti = wave, vj = tid >> 2, vec = tid & 3;
        const bf16* pq = (const bf16*)(ws + WS_QT) + it0 * 16384 + (ti * 8) * 512 + lane * 8;
        const bf16* pp = (const bf16*)(ws + WS_PC) + it0 * 4096 + (ti * 2) * 512 + lane * 8;
        const bf16* pv = (const bf16*)(ws + WS_GV) + (tb + vj) * 4096 + h * 512 + 32 * sl + vec * 8;
        bf16* po = (bf16*)(ws + WS_GV) + (tb + 16 * ti + (lane >> 2)) * 4096 + h * 512 + 32 * sl + (lane & 3) * 8;
        LAS uchar* ot = lds + 43008 + wave * 1280;
#define GO_LOAD(Q, P, c) do { const size_t c_ = (size_t)(c); \
            _Pragma("unroll") for (int ks = 0; ks < 8; ++ks) Q[ks] = *(const GAS bf16x8*)(pq + c_ * (8 * 16384) + 512 * ks); \
            _Pragma("unroll") for (int ks = 0; ks < 2; ++ks) P[ks] = *(const GAS bf16x8*)(pp + c_ * (8 * 4096) + 512 * ks); } while (0)
#define GO_VLOAD(V, c) do { const int cc_ = (c) < 128 ? (c) : 127; V = *(const GAS v4u*)(pv + (size_t)cc_ * (64 * 4096)); } while (0)
#define GO_VSTAGE(V, buf) do { const unsigned vv_[4] = {V.x, V.y, V.z, V.w}; LAS uchar* vt_ = VT + (buf) * 4608; \
            _Pragma("unroll") for (int i = 0; i < 4; ++i) { *(LAS unsigned short*)(vt_ + (vec * 8 + 2 * i) * 144 + vj * 2) = (unsigned short)(vv_[i] & 0xffffu); *(LAS unsigned short*)(vt_ + (vec * 8 + 2 * i + 1) * 144 + vj * 2) = (unsigned short)(vv_[i] >> 16); } } while (0)
        { v4u v0_; GO_VLOAD(v0_, 0); GO_VSTAGE(v0_, 0); }
        LDS_WAIT(); __builtin_amdgcn_s_barrier(); asm volatile("" ::: "memory");
        for (int c0 = 0; c0 < 128; c0 += UN) {
            bf16x8 q[3][8], p[3][2]; v4u vr[3];
#pragma unroll
            for (int s3 = 0; s3 < 3; ++s3) GO_LOAD(q[s3], p[s3], c0 + s3);
            GO_VLOAD(vr[1], c0 + 1); GO_VLOAD(vr[2], c0 + 2);
#pragma unroll
            for (int st = 0; st < UN; ++st) {
                const int c = c0 + st;
                const LAS uchar* sb_ = Sb + (c & 1) * 16896; const LAS uchar* vt_r = VT + (c & 1) * 4608;
                f32x4 o0 = {0.f, 0.f, 0.f, 0.f}, o1 = {0.f, 0.f, 0.f, 0.f};
#pragma unroll
                for (int ks = 0; ks < 8; ++ks) { const bf16x8 s0 = *(const LAS bf16x8*)(sb_ + r16 * 528 + (32 * ks + 8 * g4) * 2), s1 = *(const LAS bf16x8*)(sb_ + (16 + r16) * 528 + (32 * ks + 8 * g4) * 2);
                    o0 = __builtin_amdgcn_mfma_f32_16x16x32_bf16(q[st % 3][ks], s0, o0, 0, 0, 0); o1 = __builtin_amdgcn_mfma_f32_16x16x32_bf16(q[st % 3][ks], s1, o1, 0, 0, 0); }
#pragma unroll
                for (int ks = 0; ks < 2; ++ks) { const bf16x8 v0 = *(const LAS bf16x8*)(vt_r + r16 * 144 + (32 * ks + 8 * g4) * 2), v1 = *(const LAS bf16x8*)(vt_r + (16 + r16) * 144 + (32 * ks + 8 * g4) * 2);
                    o0 = __builtin_amdgcn_mfma_f32_16x16x32_bf16(p[st % 3][ks], v0, o0, 0, 0, 0); o1 = __builtin_amdgcn_mfma_f32_16x16x32_bf16(p[st % 3][ks], v1, o1, 0, 0, 0); }
#pragma unroll
                for (int ii = 0; ii < 4; ++ii) { *(LAS unsigned short*)(ot + (4 * g4 + ii) * 80 + r16 * 2) = (unsigned short)f2bf(o0[ii]); *(LAS unsigned short*)(ot + (4 * g4 + ii) * 80 + 32 + r16 * 2) = (unsigned short)f2bf(o1[ii]); }
                LDS_WAIT();
                { const v4u ow_ = *(const LAS v4u*)(ot + (lane >> 2) * 80 + (lane & 3) * 16); *(GAS v4u*)(po + (size_t)c * (64 * 4096)) = ow_; }
                if (st + 3 < UN) GO_LOAD(q[st % 3], p[st % 3], c + 3);
                GO_VSTAGE(vr[(st + 1) % 3], (c + 1) & 1);
                if (st + 2 < UN) GO_VLOAD(vr[st % 3], c + 3);
                LDS_WAIT(); __builtin_amdgcn_s_barrier(); asm volatile("" ::: "memory");
            }
        }
#undef GO_LOAD
#undef GO_VLOAD
#undef GO_VSTAGE
    } else {
        const int wq = wave - 4;
        const bf16* pk = (const bf16*)(ws + WS_KD) + it0 * 16384 + (4 * wq * 2) * 512 + lane * 8;
        const float* pg = (const float*)(ws + WS_GAM) + it0 * 256 + 64 * wq + 4 * g4;
        f32x4 accS[4][2];
#pragma unroll
        for (int a = 0; a < 4; ++a) { accS[a][0] = (f32x4){0.f, 0.f, 0.f, 0.f}; accS[a][1] = (f32x4){0.f, 0.f, 0.f, 0.f}; }
#define GS_LOAD(K, Gm, c) do { const size_t c_ = (size_t)(c); \
            _Pragma("unroll") for (int td = 0; td < 4; ++td) { _Pragma("unroll") for (int ks = 0; ks < 2; ++ks) K[td][ks] = *(const GAS bf16x8*)(pk + c_ * (8 * 16384) + td * 1024 + 512 * ks); \
                Gm[td] = *(const GAS f32x4*)(pg + c_ * (8 * 256) + td * 16); } } while (0)
        LDS_WAIT(); __builtin_amdgcn_s_barrier(); asm volatile("" ::: "memory");
        for (int c0 = 0; c0 < 128; c0 += UN) {
            bf16x8 kk[3][4][2]; f32x4 gg[3][4];
#pragma unroll
            for (int s3 = 0; s3 < 3; ++s3) GS_LOAD(kk[s3], gg[s3], c0 + s3);
#pragma unroll
            for (int st = 0; st < UN; ++st) {
                const int c = c0 + st;
                const LAS uchar* vt_r = VT + (c & 1) * 4608; LAS uchar* sbn_ = Sb + ((c + 1) & 1) * 16896;
                bf16x8 vf_[2][2];
#pragma unroll
                for (int t2 = 0; t2 < 2; ++t2)
#pragma unroll
                    for (int ks = 0; ks < 2; ++ks) vf_[t2][ks] = *(const LAS bf16x8*)(vt_r + (16 * t2 + r16) * 144 + (32 * ks + 8 * g4) * 2);
#pragma unroll
                for (int td = 0; td < 4; ++td)
#pragma unroll
                    for (int t2 = 0; t2 < 2; ++t2) { f32x4 a_ = accS[td][t2] * gg[st % 3][td];
#pragma unroll
                        for (int ks = 0; ks < 2; ++ks) a_ = __builtin_amdgcn_mfma_f32_16x16x32_bf16(kk[st % 3][td][ks], vf_[t2][ks], a_, 0, 0, 0);
                        accS[td][t2] = a_; v2u w_; w_.x = pk2(a_[0], a_[1]); w_.y = pk2(a_[2], a_[3]);
                        *(LAS v2u*)(sbn_ + (16 * t2 + r16) * 528 + (64 * wq + 16 * td + 4 * g4) * 2) = w_; }
                if (st + 3 < UN) GS_LOAD(kk[st % 3], gg[st % 3], c + 3);
                LDS_WAIT(); __builtin_amdgcn_s_barrier(); asm volatile("" ::: "memory");
            }
        }
#undef GS_LOAD
    }
    VM_WAIT(); __syncthreads();
}
template <int NB> __device__ __forceinline__ void gla_post_items(uchar* ws, const float* gain, int it, int stride, int lane) {
    const int h = it & 7; v4u ow[NB], gw[NB]; size_t off[NB];
#pragma unroll
    for (int b = 0; b < NB; ++b) { const int itb = (it + b * stride < T * 8) ? it + b * stride : it;
        off[b] = (size_t)(itb >> 3) * 4096 + h * 512 + lane * 8; ow[b] = *(const GAS v4u*)((const bf16*)(ws + WS_GV) + off[b]); gw[b] = *(const GAS v4u*)((const bf16*)(ws + WS_GR) + off[b]); }
    const f32x4 g0 = *(const GAS f32x4*)(gain + h * 512 + lane * 8), g1 = *(const GAS f32x4*)(gain + h * 512 + lane * 8 + 4);
    const float gn[8] = {g0.x, g0.y, g0.z, g0.w, g1.x, g1.y, g1.z, g1.w};
#pragma unroll
    for (int b = 0; b < NB; ++b) {
        float o[8] = {bflo(ow[b].x), bfhi(ow[b].x), bflo(ow[b].y), bfhi(ow[b].y), bflo(ow[b].z), bfhi(ow[b].z), bflo(ow[b].w), bfhi(ow[b].w)};
        const float gr[8] = {bflo(gw[b].x), bfhi(gw[b].x), bflo(gw[b].y), bfhi(gw[b].y), bflo(gw[b].z), bfhi(gw[b].z), bflo(gw[b].w), bfhi(gw[b].w)};
        float ss = 0.f;
#pragma unroll
        for (int i = 0; i < 8; ++i) ss += o[i] * o[i];
        const float rr = rsqrtf(wave_sum(ss) * (1.f / 512.f) + EPS);
#pragma unroll
        for (int i = 0; i < 8; ++i) o[i] = o[i] * rr * gn[i] * (gr[i] * __builtin_amdgcn_rcpf(1.f + __expf(-gr[i])));
        v2u w; w.x = pg8::pk4_fp8(16.f * o[0], 16.f * o[1], 16.f * o[2], 16.f * o[3]); w.y = pg8::pk4_fp8(16.f * o[4], 16.f * o[5], 16.f * o[6], 16.f * o[7]);
        *(GAS v2u*)(ws + WS_OA8 + off[b]) = w; }
}

__device__ __forceinline__ void transpose_item(const float* W, int ldw, int K, bf16* WT, int k0, int nsrc0, int ndst0, int ncols, LAS float* scr, int lane) {
    { float t_[32];
#pragma unroll
      for (int i = 0; i < 32; ++i) { const int kk = 2 * i + (lane >> 5), n = lane & 31; t_[i] = (n < ncols) ? W[(size_t)(k0 + kk) * ldw + nsrc0 + n] : 0.f; }
#pragma unroll
      for (int i = 0; i < 32; ++i) scr[(2 * i + (lane >> 5)) * 33 + (lane & 31)] = t_[i]; }
    LDS_WAIT(); asm volatile("" ::: "memory");
    const int c = lane & 7;
#pragma unroll
    for (int j = 0; j < 4; ++j) { const int n = (lane >> 3) + 8 * j; const LAS float* s = scr + (8 * c) * 33 + n;
        v4u o; o.x = pk2(s[0 * 33], s[1 * 33]); o.y = pk2(s[2 * 33], s[3 * 33]); o.z = pk2(s[4 * 33], s[5 * 33]); o.w = pk2(s[6 * 33], s[7 * 33]);
        if (n < ncols) *(GAS v4u*)(WT + (size_t)(ndst0 + n) * K + k0 + 8 * c) = o; }
    LDS_WAIT(); asm volatile("" ::: "memory");
}
__device__ __forceinline__ void transpose_item8(const float* W, int ldw, int K, uchar* WT8, int k0, int nsrc0, int ndst0, int ncols, float scale, LAS float* scr, int lane) {
    { float t_[32];
#pragma unroll
      for (int i = 0; i < 32; ++i) { const int kk = 2 * i + (lane >> 5), n = lane & 31; t_[i] = (n < ncols) ? W[(size_t)(k0 + kk) * ldw + nsrc0 + n] : 0.f; }
#pragma unroll
      for (int i = 0; i < 32; ++i) scr[(2 * i + (lane >> 5)) * 33 + (lane & 31)] = t_[i] * scale; }
    LDS_WAIT(); asm volatile("" ::: "memory");
    { const int n = lane & 31, hf = lane >> 5; const LAS float* sp = scr + (32 * hf) * 33 + n; unsigned w[8];
#pragma unroll
      for (int q = 0; q < 8; ++q) w[q] = pg8::pk4_fp8(sp[(4 * q) * 33], sp[(4 * q + 1) * 33], sp[(4 * q + 2) * 33], sp[(4 * q + 3) * 33]);
      if (n < ncols) { GAS v4u* dst = (GAS v4u*)(WT8 + (size_t)(ndst0 + n) * K + k0 + 32 * hf); dst[0] = (v4u){w[0], w[1], w[2], w[3]}; dst[1] = (v4u){w[4], w[5], w[6], w[7]}; } }
    LDS_WAIT(); asm volatile("" ::: "memory");
}
__device__ __forceinline__ void rms_row_to_bf16(const float* xrow, const float* gain, bf16* orow, int lane, uchar* o8row = nullptr) {
    const GAS f32x4* xr = (const GAS f32x4*)xrow + lane; const GAS f32x4* gr = (const GAS f32x4*)gain + lane;
    float s = 0.f;
#pragma unroll
    for (int j = 0; j < 16; ++j) { const f32x4 v = xr[64 * j]; s += (v.x * v.x + v.y * v.y) + (v.z * v.z + v.w * v.w); }
    const float r = rsqrtf(wave_sum(s) * (1.f / 4096.f) + EPS);
    GAS v2u* o8 = (GAS v2u*)orow + lane;
#pragma unroll
    for (int j = 0; j < 16; ++j) { const f32x4 v = xr[64 * j], g = gr[64 * j]; const float y0 = v.x * r * g.x, y1 = v.y * r * g.y, y2 = v.z * r * g.z, y3 = v.w * r * g.w; if (orow) { v2u w; w.x = pk2(y0, y1); w.y = pk2(y2, y3); o8[64 * j] = w; }
        if (o8row) ((GAS unsigned*)o8row)[lane + 64 * j] = pg8::pk4_fp8(8.f * y0, 8.f * y1, 8.f * y2, 8.f * y3); }
}
__device__ __forceinline__ void rms_rowb_to_bf16(const bf16* xrow, const float* gain, bf16* orow, int lane, uchar* o8row) {
    const GAS v4u* xr = (const GAS v4u*)xrow + lane; const GAS f32x4* gr = (const GAS f32x4*)gain + lane * 2;
    v4u xv[8]; float s = 0.f;
#pragma unroll
    for (int j = 0; j < 8; ++j) xv[j] = xr[64 * j];
#pragma unroll
    for (int j = 0; j < 8; ++j) { const v4u a = xv[j]; const float e[8] = {bflo(a.x), bfhi(a.x), bflo(a.y), bfhi(a.y), bflo(a.z), bfhi(a.z), bflo(a.w), bfhi(a.w)};
#pragma unroll
        for (int i = 0; i < 8; ++i) s += e[i] * e[i]; }
    const float r = rsqrtf(wave_sum(s) * (1.f / 4096.f) + EPS);
#pragma unroll
    for (int j = 0; j < 8; ++j) { const v4u a = xv[j]; const f32x4 g0 = gr[128 * j], g1 = gr[128 * j + 1];
        const float y0 = bflo(a.x) * r * g0.x, y1 = bfhi(a.x) * r * g0.y, y2 = bflo(a.y) * r * g0.z, y3 = bfhi(a.y) * r * g0.w, y4 = bflo(a.z) * r * g1.x, y5 = bfhi(a.z) * r * g1.y, y6 = bflo(a.w) * r * g1.z, y7 = bfhi(a.w) * r * g1.w;
        v4u w; w.x = pk2(y0, y1); w.y = pk2(y2, y3); w.z = pk2(y4, y5); w.w = pk2(y6, y7); ((GAS v4u*)orow)[lane + 64 * j] = w;
        v2u w8; w8.x = pg8::pk4_fp8(8.f * y0, 8.f * y1, 8.f * y2, 8.f * y3); w8.y = pg8::pk4_fp8(8.f * y4, 8.f * y5, 8.f * y6, 8.f * y7); ((GAS v2u*)o8row)[lane + 64 * j] = w8; }
}

template <int NV> __device__ __forceinline__ void select16(const float (&v)[NV], bool (&sel)[NV], int lane) {
    float mx = v[0], mn = v[0];
#pragma unroll
    for (int r = 1; r < NV; ++r) { mx = fmaxf(mx, v[r]); mn = fminf(mn, v[r]); }
    mx = wave_max(mx); mn = -wave_max(-mn);
    float lo = mn - 1.0f, hi = mx; bool done = false;
    for (int it = 0; it < 36; ++it) {
        const float mid = 0.5f * (lo + hi); int c = 0;
#pragma unroll
        for (int r = 0; r < NV; ++r) c += __popcll(__ballot(v[r] > mid));
        if (c == 16) {
#pragma unroll
            for (int r = 0; r < NV; ++r) sel[r] = v[r] > mid;
            done = true; break; }
        if (c > 16) lo = mid; else hi = mid;
    }
    if (!done) {
        unsigned k[NV];
#pragma unroll
        for (int r = 0; r < NV; ++r) { unsigned x = __builtin_bit_cast(unsigned, v[r]); x ^= (x >> 31) ? 0xFFFFFFFFu : 0x80000000u; k[r] = x; }
        unsigned th = 0u;
        for (int bit = 31; bit >= 0; --bit) { const unsigned cand = th | (1u << bit); int c = 0;
#pragma unroll
            for (int r = 0; r < NV; ++r) c += __popcll(__ballot(k[r] >= cand));
            if (c >= 16) th = cand; }
        int need = 16;
#pragma unroll
        for (int r = 0; r < NV; ++r) need -= __popcll(__ballot(k[r] > th));
        const unsigned long long ltmask = (1ull << lane) - 1ull; int before = 0;
#pragma unroll
        for (int r = 0; r < NV; ++r) { const unsigned long long eq = __ballot(k[r] == th); sel[r] = (k[r] > th) || (k[r] == th && (before + __popcll(eq & ltmask)) < need); before += __popcll(eq); }
    }
}

__device__ __forceinline__ void select16_pair(const float (&a)[2], const float (&b)[2], bool (&sa)[2], bool (&sb)[2], int lane) {
    float amx = wave_max(fmaxf(a[0], a[1])), amn = -wave_max(-fminf(a[0], a[1])), bmx = wave_max(fmaxf(b[0], b[1])), bmn = -wave_max(-fminf(b[0], b[1]));
    float alo = amn - 1.0f, ahi = amx, blo = bmn - 1.0f, bhi = bmx, apiv = 0.f, bpiv = 0.f; bool ad = false, bd = false;
    for (int it = 0; it < 36 && !(ad && bd); ++it) {
        const float am = 0.5f * (alo + ahi), bm = 0.5f * (blo + bhi);
        const int ca = __popcll(__ballot(a[0] > am)) + __popcll(__ballot(a[1] > am)), cb = __popcll(__ballot(b[0] > bm)) + __popcll(__ballot(b[1] > bm));
        if (!ad) { if (ca == 16) { ad = true; apiv = am; } else if (ca > 16) alo = am; else ahi = am; }
        if (!bd) { if (cb == 16) { bd = true; bpiv = bm; } else if (cb > 16) blo = bm; else bhi = bm; }
    }
    if (ad) { sa[0] = a[0] > apiv; sa[1] = a[1] > apiv; } else select16<2>(a, sa, lane);
    if (bd) { sb[0] = b[0] > bpiv; sb[1] = b[1] > bpiv; } else select16<2>(b, sb, lane);
}

struct Args { const float* in[23]; float* out; uchar* ws; int ph_lo, ph_hi, flags, pad; };
#ifndef STAG_MERGE
#define STAG_MERGE 0
#endif
#ifndef STAG_P1
#define STAG_P1 0
#endif
#ifndef STAG_WOUT
#define STAG_WOUT 0
#endif
#ifndef STAG_PEER1
#define STAG_PEER1 0
#endif
#ifndef STAG_PEER2
#define STAG_PEER2 0
#endif
__device__ __forceinline__ void stagger_wait(unsigned ticks) {
    if (ticks) { const unsigned long long t0 = __builtin_amdgcn_s_memrealtime(); while (__builtin_amdgcn_s_memrealtime() - t0 < (unsigned long long)ticks) __builtin_amdgcn_s_sleep(2); }
}
enum { PH_PRO = 0, PH_P1 = 1, PH_PREP = 2, PH_MIX = 3, PH_MIX2 = 4, PH_MERGE = 5, PH_WOUT = 6, PH_HN = 7, PH_PQ = 8, PH_TOPK = 9, PH_PEER1 = 10, PH_PEER2 = 11, PH_N = 12 };

__global__ void __launch_bounds__(NTHR, 2) mk_fwd(Args args) {
    extern __shared__ __attribute__((aligned(16))) uchar lds_raw[];
    LAS uchar* lds = (LAS uchar*)lds_raw;
    volatile LAS unsigned* MISC = (volatile LAS unsigned*)(lds + MISC_OFF);
    int tid = threadIdx.x, lane = tid & 63, wave = __builtin_amdgcn_readfirstlane(tid >> 6);
    const int wave_s = wave;
    const int G = gridDim.x, bx = blockIdx.x;
#define REFRESH_TID() do { tid = wave_s * 64 + fresh_lane(); lane = tid & 63; wave = wave_s; gw = bx * NWAVES + wave; } while (0)
    uchar* ws = args.ws;
    unsigned* ctl = (unsigned*)(ws + WS_CTL);
    for (int u = tid; u < (LDS_BYTES - LDSCTL_OFF) / 4; u += NTHR) ((LAS unsigned*)(lds + LDSCTL_OFF))[u] = 0u;
    __syncthreads();
    const int lo = args.ph_lo, hi = args.ph_hi;
    const bool multi = (hi - lo) > 1;
#ifndef TOPK_PROBE
#define TOPK_PROBE 0
#endif
#ifndef PRO_EXTRA
#define PRO_EXTRA 0
#endif
#ifndef PROBE_MASK
#define PROBE_MASK (TOPK_PROBE ? 0x40000000 : 0)
#endif
    unsigned long long pr_acc = 0ull, pr_t0 = PROBE_MASK ? __builtin_amdgcn_s_memrealtime() : 0ull;
#define PROBE_MARK(k) do { if (PROBE_MASK) { const unsigned long long t_ = __builtin_amdgcn_s_memrealtime(); if ((PROBE_MASK >> (k)) & 1) pr_acc += t_ - pr_t0; pr_t0 = t_; } } while (0)
    XcdBarrier bar; bar.bar = ctl + CW_BAR; bar.x = 0; bar.st = nullptr;
    if (multi) bar = xcd_barrier_post(ctl + CW_BAR, MISC + 8);
#define IN(k) (lo <= (k) && (k) < hi)
#define BOTH(k) (IN(k) && IN((k) + 1))
#define GRID_BAR() xcd_barrier(bar, wave_s * 64 + fresh_lane())
    int gw = bx * NWAVES + wave; const int NGW = G * NWAVES;

    if (IN(PH_PRO)) {
        REFRESH_TID();
        LAS float* scr = (LAS float*)(lds + wave * 16384);
        const float* w_in = args.in[3]; const float* w_kv = args.in[11]; const float* w_bg = args.in[14]; const float* w_bs = args.in[15]; const float* w_bm = args.in[16];
        const float* w_out = args.in[17]; const float* w_q = args.in[19];
        bf16* win_t = (bf16*)(ws + WS_WIN_T); bf16* wkv_t = (bf16*)(ws + WS_WKV_T); bf16* wbr_t = (bf16*)(ws + WS_WBR_T); bf16* wout_t = (bf16*)(ws + WS_WOUT_T); bf16* wq_t = (bf16*)(ws + WS_WQ_T);
        constexpr int KB = D / 64;
        constexpr int I_A = KB * (12288 / 32), I_B = KB * (21504 / 32), I_G = KB, I_KV = KB * (8192 / 32), I_BR = KB * (4096 / 32), I_Q = KB * (2048 / 32);
        constexpr int NIT = I_A + I_B + I_G + I_KV + 4 * I_BR; (void)I_Q;
        for (int rep_ = 0; rep_ < 1 + (PRO_EXTRA & 1); ++rep_)
        for (int it = gw; it < NIT; it += NGW) {
            int r = it;
            if (r < I_A) { const int nb = r % 384, kb = r / 384, sc0 = nb * 32;
                const int dr = sc0 < 2048 ? sc0 : (sc0 < 4096 ? sc0 + 4096 : (sc0 < 8192 ? sc0 + 4096 : sc0 - 6144));
                if (dr < P1_NB16 * 256) transpose_item(w_in, DIN, D, win_t, kb * 64, sc0, dr, 32, scr, lane); else transpose_item8(w_in, DIN, D, ws + WS_WIN8, kb * 64, sc0, dr, 32, 512.f, scr, lane);
                continue; } r -= I_A;
            if (r < I_B) { const int nb = r % 672, kb = r / 672; transpose_item8(w_in, DIN, D, ws + WS_WIN8, kb * 64, 12304 + nb * 32, 12288 + nb * 32, 32, 512.f, scr, lane); continue; } r -= I_B;
            if (r < I_G) { transpose_item8(w_in, DIN, D, ws + WS_WIN8, r * 64, 12288, 33792, 16, 512.f, scr, lane); continue; } r -= I_G;
            if (r < I_KV) { const int nb = r % 256, kb = r / 256; transpose_item8(w_kv, 8192, D, (uchar*)wkv_t, kb * 64, nb * 32, nb * 32, 32, 512.f, scr, lane); continue; } r -= I_KV;
            if (r < 4 * I_BR) { const int w = r / I_BR, q = r % I_BR, nb = q % 128, kb = q / 128;
                const float* src = w == 0 ? w_bg : (w == 1 ? w_bs : (w == 2 ? w_bm : w_out)); uchar* dst = w < 3 ? (uchar*)wbr_t + (size_t)w * 4096 * 4096 : (uchar*)wout_t;
                transpose_item8(src, 4096, D, dst, kb * 64, nb * 32, nb * 32, 32, 512.f, scr, lane); }
        }
        {
            __syncthreads();
            LAS float* wq_s = (LAS float*)lds;
            LAS float* kh_s = (LAS float*)(lds + 64 * 132 * 4);
            const float* subk = args.in[20];
            const int ng = tid & 31, kg = tid >> 5;
            for (int rep_ = 0; rep_ < 1 + ((PRO_EXTRA >> 1) & 1); ++rep_)
            for (int it = bx; it < 16 * 64; it += G) {
                const int hp = it >> 6, kb = it & 63;
#pragma unroll
                for (int r = 0; r < 4; ++r) { const int idx = tid + 512 * r, row = idx >> 5, c4 = idx & 31;
                    *(LAS f32x4*)(wq_s + row * 132 + c4 * 4) = *(const GAS f32x4*)(w_q + (size_t)(kb * 64 + row) * 2048 + hp * 128 + c4 * 4) * args.in[18][kb * 64 + row]; }
#pragma unroll
                for (int r = 0; r < 8; ++r) { const int idx = tid + 512 * r, row = idx >> 5, c4 = idx & 31;
                    *(LAS f32x4*)(kh_s + row * 132 + c4 * 4) = *(const GAS f32x4*)(subk + ((size_t)hp * 128 + row) * 128 + c4 * 4); }
                __syncthreads();
                float acc[4][4];
#pragma unroll
                for (int i = 0; i < 4; ++i)
#pragma unroll
                    for (int j = 0; j < 4; ++j) acc[i][j] = 0.f;
                for (int d4 = 0; d4 < 32; ++d4) {
                    f32x4 a[4], b[4];
#pragma unroll
                    for (int i = 0; i < 4; ++i) { a[i] = *(const LAS f32x4*)(wq_s + (4 * kg + i) * 132 + 4 * d4); b[i] = *(const LAS f32x4*)(kh_s + (4 * ng + i) * 132 + 4 * d4); }
#pragma unroll
                    for (int i = 0; i < 4; ++i)
#pragma unroll
                        for (int j = 0; j < 4; ++j) acc[i][j] += (a[i].x * b[j].x + a[i].y * b[j].y) + (a[i].z * b[j].z + a[i].w * b[j].w);
                }
#pragma unroll
                for (int j = 0; j < 4; ++j) { v2u w; w.x = pk2(acc[0][j], acc[1][j]); w.y = pk2(acc[2][j], acc[3][j]);
                    *(GAS v2u*)(wq_t + (size_t)(hp * 128 + 4 * ng + j) * D + kb * 64 + 4 * kg) = w; }
                __syncthreads();
            }
        }
        { v4u z = {0u, 0u, 0u, 0u}; GAS v4u* p = (GAS v4u*)(ws + WS_WIN8 + (size_t)33808 * D); const size_t n16 = (size_t)240 * D / 16;
          for (size_t i = (size_t)bx * NTHR + tid; i < n16; i += (size_t)G * NTHR) p[i] = z; }
        for (int rep_ = 0; rep_ < 1 + ((PRO_EXTRA >> 2) & 1); ++rep_)
        for (int m = gw; m < T; m += NGW) rms_row_to_bf16(args.in[0] + (size_t)m * D, args.in[2], P1_NB16 ? (bf16*)(ws + WS_XN) + (size_t)m * D : nullptr, lane, ws + WS_XN8 + (size_t)m * D);
        for (int m = gw; m < BATCH * MEM; m += NGW) rms_row_to_bf16(args.in[1] + (size_t)m * D, args.in[10], nullptr, lane, ws + WS_MEMN + (size_t)m * D);
        if (BOTH(PH_PRO)) GRID_BAR();
        PROBE_MARK(PH_PRO);
    }
    if (IN(PH_P1)) {
        stagger_wait((unsigned)((bx >> 3) & 3) * STAG_P1);
        if (P1_NB16 > 0) { pg8::GemmG g{D, D, D}; SchedP1 S{ws, G, bx, false}; pg8::EpiBf16 E; pg8::gemm_phase<pg8::EpiBf16, SchedP1>(lds, g, S, E, wave_s); }
        { pg8::GemmG g{D / 2, D / 2, D / 2}; SchedP1 S{ws, G, bx, true}; pg8::EpiBf16T<true> E; pg8::gemm_phase<pg8::EpiBf16T<true>, SchedP1>(lds, g, S, E, wave_s); }
        if (BOTH(PH_P1)) GRID_BAR();
        PROBE_MARK(PH_P1);
    }
    if (IN(PH_PREP)) {
        REFRESH_TID();
        if (FAST_FLAGS & 1) {
            bf16* kvm = (bf16*)(ws + WS_KVM); const float* gq = args.in[12]; const float* gk = args.in[13];
            for (int it = gw; it < 512 * 4; it += NGW) { const int j = it >> 2, h = it & 3; bf16* p = kvm + (size_t)j * 8192 + h * 1024 + lane * 16;
                const v4u a = *(const GAS v4u*)p, b2 = *(const GAS v4u*)(p + 8);
                float v[16] = {bflo(a.x), bfhi(a.x), bflo(a.y), bfhi(a.y), bflo(a.z), bfhi(a.z), bflo(a.w), bfhi(a.w), bflo(b2.x), bfhi(b2.x), bflo(b2.y), bfhi(b2.y), bflo(b2.z), bfhi(b2.z), bflo(b2.w), bfhi(b2.w)};
                float ss = 0.f;
#pragma unroll
                for (int i = 0; i < 16; ++i) ss += v[i] * v[i];
                const float r = rsqrtf(wave_sum(ss) * (1.f / 1024.f) + EPS) * 0.03125f;
#pragma unroll
                for (int i = 0; i < 16; ++i) v[i] *= r * gk[lane * 16 + i] * gq[lane * 16 + i];
                v4u o0, o1; o0.x = pk2(v[0], v[1]); o0.y = pk2(v[2], v[3]); o0.z = pk2(v[4], v[5]); o0.w = pk2(v[6], v[7]); o1.x = pk2(v[8], v[9]); o1.y = pk2(v[10], v[11]); o1.z = pk2(v[12], v[13]); o1.w = pk2(v[14], v[15]);
                *(GAS v4u*)p = o0; *(GAS v4u*)(p + 8) = o1; }
            for (int it = gw; it < 4096; it += NGW) { const int b = it >> 11, r = it & 2047, cg = r >> 5, jg = r & 31, c = cg * 64 + lane; unsigned short x[8];
#pragma unroll
                for (int i = 0; i < 8; ++i) x[i] = kvm[(size_t)(b * 256 + jg * 8 + i) * 8192 + 4096 + c];
                v4u w; w.x = x[0] | ((unsigned)x[1] << 16); w.y = x[2] | ((unsigned)x[3] << 16); w.z = x[4] | ((unsigned)x[5] << 16); w.w = x[6] | ((unsigned)x[7] << 16);
                *(GAS v4u*)((bf16*)(ws + WS_VTM) + ((size_t)b * 4096 + c) * 256 + jg * 8) = w; }
            for (int it0 = gw; it0 < T * 4; it0 += 8 * NGW) {
                v4u ra[8], rb[8];
#pragma unroll
                for (int u = 0; u < 8; ++u) { const int it_ = it0 + u * NGW, it = it_ < T * 4 ? it_ : it0; const bf16* p = (const bf16*)(ws + WS_MQ) + (size_t)(it >> 2) * 4096 + (it & 3) * 1024 + lane * 16;
                    ra[u] = *(const GAS v4u*)p; rb[u] = *(const GAS v4u*)(p + 8); }
#pragma unroll
                for (int u = 0; u < 8; ++u) { const int it = it0 + u * NGW; const unsigned w8[8] = {ra[u].x, ra[u].y, ra[u].z, ra[u].w, rb[u].x, rb[u].y, rb[u].z, rb[u].w}; float ss = 0.f;
#pragma unroll
                    for (int i = 0; i < 8; ++i) { const float lo_ = bflo(w8[i]), hi_ = bfhi(w8[i]); ss += lo_ * lo_ + hi_ * hi_; }
                    ss = wave_sum(ss);
                    if (lane == 0 && it < T * 4) ((float*)(ws + WS_RQ))[it] = rsqrtf(ss * (1.f / 1024.f) + EPS); } }
        }
        if (FAST_FLAGS & 4) {
            __syncthreads();
            for (int it = bx; it < 2048; it += G) gla_prep_item(lds, ws, args.in[4], args.in[5], it, tid);
        }
        if (BOTH(PH_PREP)) GRID_BAR();
        PROBE_MARK(PH_PREP);
    }
    if (IN(PH_MIX)) {
        if (FAST_FLAGS & 4) {
            REFRESH_TID();
            for (int u0 = bx; u0 < 256; u0 += G) { const int u = (G == 256) ? ((u0 & 7) * 32 + (u0 >> 3)) : u0; gla_scan_unit(lds, ws, u, tid); }
        }
        PROBE_MARK(12);
        if (FAST_FLAGS & 1) {
            pg8::GemmG g{4096, 8192, 1024}; SchedMemS S{ws, G, bx}; pg8::EpiMemS E{(const float*)(ws + WS_RQ), (bf16*)(ws + WS_PM), (LAS float*)(lds + LDSCTL_OFF + 2048)};
            pg8::gemm_phase<pg8::EpiMemS, SchedMemS>(lds, g, S, E, wave_s);
        }
        PROBE_MARK(13);
        if (FAST_FLAGS & 2) {
            REFRESH_TID();
            for (int u = bx; u < 1024; u += G) { const int b = u >> 9, blk = (u >> 3) & 63, kvh = u & 7;
                swa_unit(lds, (const bf16*)(ws + WS_SQ), (const bf16*)(ws + WS_SK), (const bf16*)(ws + WS_SV), ws + WS_OB8, args.in[7], args.in[8], args.in[9], b, blk, kvh, tid); }
        }
        if (BOTH(PH_MIX)) GRID_BAR();
        PROBE_MARK(PH_MIX);
    }
    if (IN(PH_MIX2)) {
        if (FAST_FLAGS & 1) {
            pg8::GemmG g{1024, 256, 256}; SchedMemO S{ws, G, bx}; pg8::EpiOutFp8 E;
            pg8::gemm_phase<pg8::EpiOutFp8, SchedMemO>(lds, g, S, E, wave_s);
        }
        if (FAST_FLAGS & 4) {
            REFRESH_TID();
            for (int it = gw; it < T * 8; it += 4 * NGW) gla_post_items<4>(ws, args.in[6], it, NGW, lane);
        }
        if (BOTH(PH_MIX2)) GRID_BAR();
        PROBE_MARK(PH_MIX2);
    }
    if (IN(PH_MERGE)) {
        stagger_wait((unsigned)((bx >> 3) & 3) * STAG_MERGE);
        pg8::GemmG g{D / 2, D / 2, D / 2}; SchedMerge S{ws, G, bx}; pg8::EpiMerge E{(const bf16*)(ws + WS_GATE), ws + WS_MIX8};
        pg8::gemm_phase<pg8::EpiMerge, SchedMerge>(lds, g, S, E, wave_s);
        if (BOTH(PH_MERGE)) GRID_BAR();
        PROBE_MARK(PH_MERGE);
    }
    if (IN(PH_WOUT)) {
        stagger_wait((unsigned)((bx >> 3) & 3) * STAG_WOUT);
        pg8::GemmG g{D / 2, D / 2, D / 2}; SchedPlain S{(const char*)(ws + WS_MIX8), (const char*)(ws + WS_WOUT_T), nullptr, 64, 16, D / 2, 4, G, bx, 0.00006103515625f}; EpiWoutHB E{args.in[0], (bf16*)(ws + WS_HB)};
        pg8::gemm_phase<EpiWoutHB, SchedPlain>(lds, g, S, E, wave_s);
        if (BOTH(PH_WOUT)) GRID_BAR();
        PROBE_MARK(PH_WOUT);
    }
    if (IN(PH_HN)) {
        PROBE_MARK(PH_HN);
    }
    if (IN(PH_PQ)) {
        pg8::GemmG g{D, D, D}; SchedPlain S{(const char*)(ws + WS_HB), (const char*)(ws + WS_WQ_T), (char*)(ws + WS_QP), 64, 8, D, 4, G, bx, 1.f}; pg8::EpiF32 E{nullptr};
        pg8::gemm_phase<pg8::EpiF32, SchedPlain>(lds, g, S, E, wave_s);
        if (BOTH(PH_PQ)) GRID_BAR();
        PROBE_MARK(PH_PQ);
    }
    if (IN(PH_TOPK)) {
        REFRESH_TID();
        LAS float* grow0 = (LAS float*)lds;
        LAS float* topv = (LAS float*)(lds + LDSCTL_OFF + 2048) + wave * 32;
        LAS int* topi = (LAS int*)(lds + LDSCTL_OFF + 2048 + 1024) + wave * 32;
        for (int i = tid; i < 32768; i += NTHR) grow0[i] = 0.f;
        LAS float* hsq = (LAS float*)(lds + LDSCTL_OFF + 4096);
        const GAS v4u* hsl = (const GAS v4u*)((const bf16*)(ws + WS_HB)) + wave * 64 + lane;
        v4u hcur = hsl[(size_t)(bx < T ? bx : 0) * 512];
        { const float e8[8] = {bflo(hcur.x), bfhi(hcur.x), bflo(hcur.y), bfhi(hcur.y), bflo(hcur.z), bfhi(hcur.z), bflo(hcur.w), bfhi(hcur.w)}; float q = 0.f;
#pragma unroll
          for (int i = 0; i < 8; ++i) q += e8[i] * e8[i];
          q = wave_sum(q); if (lane == 0) hsq[wave] = q; }
        __syncthreads();
        const float* sc = (const float*)(ws + WS_QP); bf16* ga = (bf16*)(ws + WS_GA);
        const unsigned long long ltmask = (1ull << lane) - 1ull;
        const float* usrc = args.in[21]; const float* vsrc = args.in[22]; const int gw8 = bx * 8 + wave; int jj = 0;
        int par = 0; float nv_[2][2];
        { const float* sp0 = sc + (size_t)bx * 2048 + wave * 256;
#pragma unroll
          for (int p = 0; p < 2; ++p) { nv_[p][0] = sp0[p * 128 + lane]; nv_[p][1] = sp0[p * 128 + 64 + lane]; } }
        asm volatile("" : "+v"(nv_[0][0]), "+v"(nv_[0][1]), "+v"(nv_[1][0]), "+v"(nv_[1][1]));
        for (int t = bx; t < T; t += G, par ^= 1, ++jj) {
            LAS float* grow = grow0 + par * 16384;
            const unsigned long long tk0_ = TOPK_PROBE ? __builtin_amdgcn_s_memrealtime() : 0ull;
            float v[2][2];
#pragma unroll
            for (int p = 0; p < 2; ++p) { v[p][0] = nv_[p][0]; v[p][1] = nv_[p][1]; }
            { const int tn = (t + G < T) ? t + G : t; const float* spn = sc + (size_t)tn * 2048 + wave * 256;
#pragma unroll
              for (int p = 0; p < 2; ++p) { nv_[p][0] = spn[p * 128 + lane]; nv_[p][1] = spn[p * 128 + 64 + lane]; } }
            const int cit0 = (jj >> 1) * (8 * G) + gw8, cit = cit0 < 65535 ? cit0 : 65535, chalf = jj & 1;
            const int tnx = (t + G < T) ? t + G : t; const v4u hnx = hsl[(size_t)tnx * 512];
            float rstd; { const f32x4 p0 = *(const LAS f32x4*)(hsq + par * 8), p1 = *(const LAS f32x4*)(hsq + par * 8 + 4); rstd = rsqrtf((((p0.x + p0.y) + (p0.z + p0.w)) + ((p1.x + p1.y) + (p1.z + p1.w))) * (1.f / 4096.f) + EPS); }
            const GAS f32x4* up = (const GAS f32x4*)(usrc + (size_t)cit * 1024 + chalf * 512) + lane * 2;
            const GAS f32x4* ugp = (const GAS f32x4*)(args.in[18] + ((cit * 1024 + chalf * 512) & 4095)) + lane * 2; const f32x4 ug0 = ugp[0], ug1 = ugp[1];
            const int cvt0 = (jj >> 3) * (8 * G) + gw8, cvt = cvt0 < 16383 ? cvt0 : 16383, cv8 = jj & 7;
            const GAS float* vp = (const GAS float*)(vsrc + ((size_t)(cvt >> 6) * 64 + cv8 * 8) * 4096 + (cvt & 63) * 64);
            const f32x4 cu0 = up[0], cu1 = up[1]; float cv_[8];
#pragma unroll
            for (int q = 0; q < 8; ++q) cv_[q] = vp[q * 4096 + lane];
            bool slp[2][2]; select16_pair(v[0], v[1], slp[0], slp[1], lane);
#pragma unroll
            for (int p = 0; p < 2; ++p) {
                const bool sl[2] = {slp[p][0], slp[p][1]};
                const unsigned long long m0 = __ballot(sl[0]), m1 = __ballot(sl[1]);
                if (sl[0]) { const int slot = __popcll(m0 & ltmask); topv[p * 16 + slot] = v[p][0]; topi[p * 16 + slot] = lane; }
                if (sl[1]) { const int slot = __popcll(m0) + __popcll(m1 & ltmask); topv[p * 16 + slot] = v[p][1]; topi[p * 16 + slot] = 64 + lane; }
            }
            LDS_WAIT();
            float cv[4];
#pragma unroll
            for (int r = 0; r < 4; ++r) { const int c = lane + 64 * r; cv[r] = topv[c >> 4] + topv[16 + (c & 15)]; }
            bool sel[4]; select16<4>(cv, sel, lane);
            float mx = fmaxf(fmaxf(cv[0], cv[1]), fmaxf(cv[2], cv[3]));
            mx = wave_max(mx);
            float e[4], es = 0.f;
#pragma unroll
            for (int r = 0; r < 4; ++r) { e[r] = sel[r] ? __expf((cv[r] - mx) * rstd) : 0.f; es += e[r]; }
            es = wave_sum(es);
            const float inv = 1.0f / es;
#pragma unroll
            for (int r = 0; r < 4; ++r) if (sel[r]) { const int c = lane + 64 * r; const int ex = topi[c >> 4] * 128 + topi[16 + (c & 15)]; (void)__hip_atomic_fetch_add(grow + ex, e[r] * inv, __ATOMIC_RELAXED, __HIP_MEMORY_SCOPE_WORKGROUP); }
            if (TOPK_PROBE == 1) pr_acc += __builtin_amdgcn_s_memrealtime() - tk0_;
            {   const float e8[8] = {bflo(hnx.x), bfhi(hnx.x), bflo(hnx.y), bfhi(hnx.y), bflo(hnx.z), bfhi(hnx.z), bflo(hnx.w), bfhi(hnx.w)}; float q = 0.f;
#pragma unroll
                for (int i = 0; i < 8; ++i) q += e8[i] * e8[i];
                q = wave_sum(q); if (lane == 0) hsq[(par ^ 1) * 8 + wave] = q;
                const float r8 = 8.f * rstd; v2u wh; wh.x = pg8::pk4_fp8(r8 * bflo(hcur.x), r8 * bfhi(hcur.x), r8 * bflo(hcur.y), r8 * bfhi(hcur.y)); wh.y = pg8::pk4_fp8(r8 * bflo(hcur.z), r8 * bfhi(hcur.z), r8 * bflo(hcur.w), r8 * bfhi(hcur.w));
                ((GAS v2u*)(ws + WS_HN8 + (size_t)t * D))[wave * 64 + lane] = wh; hcur = hnx; }
            {   v2u wu, wv; wu.x = pg8::pk4_fp8(512.f * cu0.x * ug0.x, 512.f * cu0.y * ug0.y, 512.f * cu0.z * ug0.z, 512.f * cu0.w * ug0.w); wu.y = pg8::pk4_fp8(512.f * cu1.x * ug1.x, 512.f * cu1.y * ug1.y, 512.f * cu1.z * ug1.z, 512.f * cu1.w * ug1.w);
                wv.x = pg8::pk4_fp8(16.f * cv_[0], 16.f * cv_[1], 16.f * cv_[2], 16.f * cv_[3]); wv.y = pg8::pk4_fp8(16.f * cv_[4], 16.f * cv_[5], 16.f * cv_[6], 16.f * cv_[7]);
                ((GAS v2u*)(ws + WS_U8 + (size_t)cit * 1024 + chalf * 512))[lane] = wu;
                ((GAS v2u*)(ws + WS_V8T + (size_t)(cvt >> 6) * (4096 * 64) + (size_t)((cvt & 63) * 64) * 64 + cv8 * 8))[lane * 8] = wv; }
            asm volatile("" : "+v"(nv_[0][0]), "+v"(nv_[0][1]), "+v"(nv_[1][0]), "+v"(nv_[1][1]));
            LDS_WAIT(); __builtin_amdgcn_s_barrier(); asm volatile("" ::: "memory");
            {
                LAS f32x4* rp = (LAS f32x4*)grow + tid; GAS unsigned* gp = (GAS unsigned*)((uchar*)ga + (size_t)t * 16384) + tid;
#pragma unroll
                for (int q = 0; q < 8; ++q) { const f32x4 a = rp[512 * q] * 64.f; gp[512 * q] = pg8::pk4_fp8(a.x, a.y, a.z, a.w); rp[512 * q] = (f32x4){0.f, 0.f, 0.f, 0.f}; }
            }
            if (TOPK_PROBE == 2) pr_acc += __builtin_amdgcn_s_memrealtime() - tk0_;
        }
        for (int j2 = jj >> 1; j2 * (8 * G) + gw8 < 65536; ++j2) { const int cit = j2 * (8 * G) + gw8; const GAS f32x4* up = (const GAS f32x4*)usrc + ((size_t)cit * 64 + lane) * 4; v4u w;
            const GAS f32x4* tg = (const GAS f32x4*)(args.in[18] + ((cit * 1024) & 4095)) + lane * 4;
            { const f32x4 a = up[0] * tg[0] * 512.f; w.x = pg8::pk4_fp8(a.x, a.y, a.z, a.w); } { const f32x4 a = up[1] * tg[1] * 512.f; w.y = pg8::pk4_fp8(a.x, a.y, a.z, a.w); }
            { const f32x4 a = up[2] * tg[2] * 512.f; w.z = pg8::pk4_fp8(a.x, a.y, a.z, a.w); } { const f32x4 a = up[3] * tg[3] * 512.f; w.w = pg8::pk4_fp8(a.x, a.y, a.z, a.w); }
            ((GAS v4u*)(ws + WS_U8))[(size_t)cit * 64 + lane] = w; }
        for (int j3 = jj >> 3; j3 * (8 * G) + gw8 < 16384; ++j3) { const int cvt = j3 * (8 * G) + gw8;
            for (int c8 = 0; c8 < 8; ++c8) { const GAS float* vp = (const GAS float*)(vsrc + ((size_t)(cvt >> 6) * 64 + c8 * 8) * 4096 + (cvt & 63) * 64); float c_[8];
#pragma unroll
                for (int q = 0; q < 8; ++q) c_[q] = 16.f * vp[q * 4096 + lane];
                v2u w; w.x = pg8::pk4_fp8(c_[0], c_[1], c_[2], c_[3]); w.y = pg8::pk4_fp8(c_[4], c_[5], c_[6], c_[7]);
                ((GAS v2u*)(ws + WS_V8T + (size_t)(cvt >> 6) * (4096 * 64) + (size_t)((cvt & 63) * 64) * 64 + c8 * 8))[lane * 8] = w; } }
        LDS_WAIT(); __syncthreads();
        if (BOTH(PH_TOPK)) GRID_BAR();
        PROBE_MARK(PH_TOPK);
    }
    if (IN(PH_PEER1)) {
        stagger_wait((unsigned)((bx >> 3) & 3) * STAG_PEER1);
        pg8::GemmG g{2048, 2048, 2048};
        SchedPlain S{(const char*)(ws + WS_HN8), (const char*)(ws + WS_U8), (char*)(ws + WS_A8), 64, 64, 2048, 1, G, bx, 1.f}; pg8::EpiPeerA8 E{(const uchar*)(ws + WS_GA), ws + WS_A8};
        pg8::gemm_phase<pg8::EpiPeerA8, SchedPlain>(lds, g, S, E, wave_s);
        if (BOTH(PH_PEER1)) GRID_BAR();
        PROBE_MARK(PH_PEER1);
    }
    if (IN(PH_PEER2)) {
        stagger_wait((unsigned)((bx >> 3) & 3) * STAG_PEER2);
        pg8::GemmG g{8192, 4096 * 64, 8192}; SchedPeer2 S{(const char*)(ws + WS_A8), (const char*)(ws + WS_V8T), nullptr, G, bx, 0.0009765625f}; EpiPeer2 E{(const bf16*)(ws + WS_HB), args.out};
        pg8::gemm_phase<EpiPeer2, SchedPeer2>(lds, g, S, E, wave_s);
        PROBE_MARK(PH_PEER2);
    }
    if (PROBE_MASK) { const unsigned long long t0_ = __builtin_amdgcn_s_memrealtime(); while (__builtin_amdgcn_s_memrealtime() - t0_ < pr_acc) __builtin_amdgcn_s_sleep(8); }
#undef IN
#undef BOTH
#undef GRID_BAR
}

namespace nv {
__device__ __forceinline__ float ldb(const bf16* p) { return bf2f(*p); }
__device__ __forceinline__ float block_sum(float v, float* red) {
    v = wave_sum(v); __syncthreads();
    if ((threadIdx.x & 63) == 0) red[threadIdx.x >> 6] = v;
    __syncthreads();
    float s = 0.f; for (int i = 0; i < (int)(blockDim.x >> 6); ++i) s += red[i];
    return s;
}
__device__ __forceinline__ float block_max(float v, float* red) {
    v = wave_max(v); __syncthreads();
    if ((threadIdx.x & 63) == 0) red[threadIdx.x >> 6] = v;
    __syncthreads();
    float s = red[0]; for (int i = 1; i < (int)(blockDim.x >> 6); ++i) s = fmaxf(s, red[i]);
    return s;
}
__global__ void k_headnorm(bf16* x, long ldx, int nheads, int hd, const float* gain, long nrows) {
    const long w = ((long)blockIdx.x * blockDim.x + threadIdx.x) >> 6; const int lane = threadIdx.x & 63;
    if (w >= nrows * nheads) return;
    const long r = w / nheads; const int h = (int)(w % nheads);
    bf16* p = x + r * ldx + (long)h * hd;
    float s = 0.f;
    for (int i = lane; i < hd; i += 64) { float v = ldb(p + i); s += v * v; }
    s = wave_sum(s);
    const float rr = rsqrtf(s / (float)hd + EPS);
    for (int i = lane; i < hd; i += 64) p[i] = (bf16)f2bf(ldb(p + i) * rr * gain[i]);
}
__global__ void k_gla_decay(const bf16* glrp, const float* wup, const float* bias, float* dec) {
    const long i = (long)blockIdx.x * blockDim.x + threadIdx.x;
    if (i >= (long)T * 2048) return;
    const long t = i / 2048; const int c = (int)(i % 2048);
    const bf16* g = glrp + t * 256;
    float s = bias[c];
    for (int r = 0; r < 16; ++r) s = fmaf(ldb(g + r), wup[r * 2048 + c], s);
    const float ls = fminf(s, 0.f) - log1pf(expf(-fabsf(s)));
    dec[i] = expf(ls * (1.0f / 16.0f));
}
__global__ __launch_bounds__(256) void k_gla_scan(const bf16* gq, const bf16* gk, bf16* gv, const float* dec) {
    const int h = blockIdx.y, e = blockIdx.x * 64 + (threadIdx.x >> 2), qd = threadIdx.x & 3; const long t0 = (long)blockIdx.z * SEQ;
    float S[64];
#pragma unroll
    for (int i = 0; i < 64; ++i) S[i] = 0.f;
    for (long t = t0; t < t0 + SEQ; ++t) {
        const bf16* pq = gq + t * 2048 + h * 256 + qd * 64; const bf16* pk = gk + t * 2048 + h * 256 + qd * 64; const float* pa = dec + t * 2048 + h * 256 + qd * 64;
        const float v = ldb(gv + t * 4096 + h * 512 + e);
        float o = 0.f;
#pragma unroll
        for (int i = 0; i < 64; i += 4) {
            const v2u qw = *(const v2u*)(pq + i), kw = *(const v2u*)(pk + i); const float4 a4 = *(const float4*)(pa + i);
            S[i + 0] = fmaf(a4.x, S[i + 0], bflo(kw.x) * v); o = fmaf(bflo(qw.x), S[i + 0], o);
            S[i + 1] = fmaf(a4.y, S[i + 1], bfhi(kw.x) * v); o = fmaf(bfhi(qw.x), S[i + 1], o);
            S[i + 2] = fmaf(a4.z, S[i + 2], bflo(kw.y) * v); o = fmaf(bflo(qw.y), S[i + 2], o);
            S[i + 3] = fmaf(a4.w, S[i + 3], bfhi(kw.y) * v); o = fmaf(bfhi(qw.y), S[i + 3], o);
        }
        o += __shfl_xor(o, 1); o += __shfl_xor(o, 2);
        if (qd == 0) gv[t * 4096 + h * 512 + e] = (bf16)f2bf(o);
    }
}
__global__ void k_gla_post(bf16* oa, const bf16* gr, const float* gain) {
    const long w = ((long)blockIdx.x * blockDim.x + threadIdx.x) >> 6; const int lane = threadIdx.x & 63;
    if (w >= (long)T * 8) return;
    const long t = w >> 3; const int h = (int)(w & 7);
    bf16* p = oa + t * 4096 + h * 512; const bf16* g = gr + t * 4096 + h * 512;
    float s = 0.f;
    for (int i = lane; i < 512; i += 64) { float v = ldb(p + i); s += v * v; }
    s = wave_sum(s);
    const float rr = rsqrtf(s / 512.f + EPS);
    for (int i = lane; i < 512; i += 64) { const float gg = ldb(g + i); p[i] = (bf16)f2bf(ldb(p + i) * rr * gain[h * 512 + i] * (gg / (1.f + expf(-gg)))); }
}
__global__ __launch_bounds__(256) void k_swa(bf16* sq, const bf16* sk, const bf16* sv, const float* sinks) {
    __shared__ float qs[4][64];
    __shared__ float ps[4][128];
    const int wl = threadIdx.x >> 6, lane = threadIdx.x & 63;
    const long w = (long)blockIdx.x * 4 + wl;
    const long t = w >> 6; const int hq = (int)(w & 63), kvh = hq >> 3; const long tb = (t / SEQ) * SEQ;
    qs[wl][lane] = ldb(sq + t * 4096 + hq * 64 + lane);
    __syncthreads();
    const float sink = sinks[hq];
    float sc[2];
#pragma unroll
    for (int r = 0; r < 2; ++r) {
        const long key = t - 127 + lane + r * 64;
        float s = -INFINITY;
        if (key >= tb) {
            const bf16* kp = sk + key * 512 + kvh * 64;
            float a = 0.f;
            for (int d = 0; d < 64; ++d) a = fmaf(qs[wl][d], ldb(kp + d), a);
            s = a * 0.125f;
        }
        sc[r] = s;
    }
    const float m = fmaxf(wave_max(fmaxf(sc[0], sc[1])), sink);
    const float p0 = expf(sc[0] - m), p1 = expf(sc[1] - m);
    const float den = wave_sum(p0 + p1) + expf(sink - m);
    ps[wl][lane] = p0 / den; ps[wl][lane + 64] = p1 / den;
    __syncthreads();
    float o = 0.f;
    for (int j = 0; j < 128; ++j) { const long key = t - 127 + j; if (key >= tb) o = fmaf(ps[wl][j], ldb(sv + key * 512 + kvh * 64 + lane), o); }
    sq[t * 4096 + hq * 64 + lane] = (bf16)f2bf(o);
}
__global__ __launch_bounds__(256) void k_memattn(bf16* mq, const bf16* kvm) {
    __shared__ float qs[8][1024];
    __shared__ float ps[8][256];
    __shared__ float red[8];
    const int hd = blockIdx.y; const long t0 = (long)blockIdx.x * 8; const int tid = threadIdx.x; const long b = t0 / SEQ;
    const bf16* kv = kvm + b * 256 * 8192;
    for (int i = tid; i < 8 * 1024; i += 256) qs[i >> 10][i & 1023] = ldb(mq + (t0 + (i >> 10)) * 4096 + hd * 1024 + (i & 1023));
    __syncthreads();
    float s[8];
#pragma unroll
    for (int r = 0; r < 8; ++r) s[r] = 0.f;
    const bf16* kp = kv + (long)tid * 8192 + hd * 1024;
    for (int d = 0; d < 1024; ++d) { const float kk = ldb(kp + d);
#pragma unroll
        for (int r = 0; r < 8; ++r) s[r] = fmaf(qs[r][d], kk, s[r]); }
    for (int r = 0; r < 8; ++r) {
        const float v = s[r] * 0.03125f;
        const float m = block_max(v, red);
        const float p = expf(v - m);
        const float den = block_sum(p, red);
        ps[r][tid] = p / den;
    }
    __syncthreads();
    float o[8][4];
#pragma unroll
    for (int r = 0; r < 8; ++r)
#pragma unroll
        for (int c = 0; c < 4; ++c) o[r][c] = 0.f;
    for (int j = 0; j < 256; ++j) {
        const bf16* vp = kv + (long)j * 8192 + 4096 + hd * 1024;
        float vv[4];
#pragma unroll
        for (int c = 0; c < 4; ++c) vv[c] = ldb(vp + tid + c * 256);
#pragma unroll
        for (int r = 0; r < 8; ++r) { const float p = ps[r][j];
#pragma unroll
            for (int c = 0; c < 4; ++c) o[r][c] = fmaf(p, vv[c], o[r][c]); }
    }
#pragma unroll
    for (int r = 0; r < 8; ++r)
#pragma unroll
        for (int c = 0; c < 4; ++c) mq[(t0 + r) * 4096 + hd * 1024 + tid + c * 256] = (bf16)f2bf(o[r][c]);
}
__global__ __launch_bounds__(256) void k_peer(float* io, const bf16* hn, const float* qp, const float* subk, const float* ut, const float* vt) {
    __shared__ float xs[4096];
    __shared__ float sc[2][128];
    __shared__ float tops[2][16];
    __shared__ int topi[2][16];
    __shared__ float cand[256];
    __shared__ float bests[16];
    __shared__ int beste[16];
    __shared__ float gate_s[128];
    __shared__ int exp_s[128];
    __shared__ float coef[128];
    const long t = blockIdx.x; const int tid = threadIdx.x, lane = tid & 63, wv = tid >> 6;
    for (int i = tid; i < 4096; i += 256) xs[i] = ldb(hn + t * 4096 + i);
    __syncthreads();
    for (int h = 0; h < 8; ++h) {
        { const int p = tid >> 7, n = tid & 127; const float* q = qp + t * 2048 + h * 256 + p * 128; const float* kk = subk + (((long)h * 2 + p) * 128 + n) * 128;
          float s = 0.f; for (int d = 0; d < 128; ++d) s = fmaf(q[d], kk[d], s); sc[p][n] = s; }
        __syncthreads();
        { const int p = tid >> 7, n = tid & 127; const float s = sc[p][n]; int rank = 0;
          for (int j = 0; j < 128; ++j) { const float o = sc[p][j]; rank += (o > s || (o == s && j < n)) ? 1 : 0; }
          if (rank < 16) { tops[p][rank] = s; topi[p][rank] = n; } }
        __syncthreads();
        cand[tid] = tops[0][tid >> 4] + tops[1][tid & 15];
        __syncthreads();
        { const float s = cand[tid]; int rank = 0;
          for (int j = 0; j < 256; ++j) { const float o = cand[j]; rank += (o > s || (o == s && j < tid)) ? 1 : 0; }
          if (rank < 16) { bests[rank] = s; beste[rank] = topi[0][tid >> 4] * 128 + topi[1][tid & 15]; } }
        __syncthreads();
        if (tid < 16) { const float m = bests[0]; float den = 0.f; for (int j = 0; j < 16; ++j) den += expf(bests[j] - m);
            gate_s[h * 16 + tid] = expf(bests[tid] - m) / den; exp_s[h * 16 + tid] = beste[tid]; }
        __syncthreads();
    }
    for (int j = wv * 32; j < wv * 32 + 32; ++j) {
        const float* up = ut + (long)exp_s[j] * 4096;
        float s = 0.f;
        for (int i = lane * 4; i < 4096; i += 256) { const float4 u4 = *(const float4*)(up + i); s = fmaf(u4.x, xs[i], s); s = fmaf(u4.y, xs[i + 1], s); s = fmaf(u4.z, xs[i + 2], s); s = fmaf(u4.w, xs[i + 3], s); }
        s = wave_sum(s);
        if (lane == 0) coef[j] = gate_s[j] * 0.5f * s * (1.0f + erff(s * 0.70710678118654752f));
    }
    __syncthreads();
    float y[16];
#pragma unroll
    for (int c = 0; c < 16; ++c) y[c] = 0.f;
    for (int j = 0; j < 128; ++j) {
        const float* vp = vt + (long)exp_s[j] * 4096; const float cf = coef[j];
#pragma unroll
        for (int c = 0; c < 4; ++c) { const float4 v4 = *(const float4*)(vp + c * 1024 + tid * 4); y[c * 4] = fmaf(cf, v4.x, y[c * 4]); y[c * 4 + 1] = fmaf(cf, v4.y, y[c * 4 + 1]); y[c * 4 + 2] = fmaf(cf, v4.z, y[c * 4 + 2]); y[c * 4 + 3] = fmaf(cf, v4.w, y[c * 4 + 3]); }
    }
#pragma unroll
    for (int c = 0; c < 4; ++c) { float4 o = *(float4*)(io + t * 4096 + c * 1024 + tid * 4); o.x += y[c * 4]; o.y += y[c * 4 + 1]; o.z += y[c * 4 + 2]; o.w += y[c * 4 + 3]; *(float4*)(io + t * 4096 + c * 1024 + tid * 4) = o; }
}
}

#ifndef DIFFTEST
#define DIFFTEST 0
#endif
namespace dbg {
__global__ void k_diff(const bf16* a, const bf16* b, size_t n, float* acc) {
    float d2 = 0.f, r2 = 0.f;
    for (size_t i = (size_t)blockIdx.x * blockDim.x + threadIdx.x; i < n; i += (size_t)gridDim.x * blockDim.x) { const float x = bf2f(a[i]), y = bf2f(b[i]); d2 += (x - y) * (x - y); r2 += y * y; }
    d2 = wave_sum(d2); r2 = wave_sum(r2);
    if ((threadIdx.x & 63) == 0) { atomicAdd(acc, d2); atomicAdd(acc + 1, r2); }
}
__global__ void k_scale(float* out, size_t n, const float* acc, float amp) {
    const float f = 1.0f + amp * sqrtf(acc[0] / fmaxf(acc[1], 1e-30f));
    for (size_t i = (size_t)blockIdx.x * blockDim.x + threadIdx.x; i < n; i += (size_t)gridDim.x * blockDim.x) out[i] *= f;
}
}
constexpr size_t WS_DBG_A = WS_END, WS_DBG_B = WS_END + 128 * MiB;

extern "C" void kernel_launch(void* const* d_in, const int* in_sizes, int n_in, void* d_out, int out_size, void* d_ws, size_t ws_size, hipStream_t stream) {
    static int grid = 0;
    if (grid == 0) {
        int dev = 0, cus = 0, per_cu = 0;
        if (hipGetDevice(&dev) != hipSuccess || hipDeviceGetAttribute(&cus, hipDeviceAttributeMultiprocessorCount, dev) != hipSuccess) { grid = -1; return; }
        if (hipFuncSetAttribute((const void*)mk_fwd, hipFuncAttributeMaxDynamicSharedMemorySize, LDS_BYTES) != hipSuccess) { grid = -1; return; }
        if (hipOccupancyMaxActiveBlocksPerMultiprocessor(&per_cu, (const void*)mk_fwd, NTHR, LDS_BYTES) != hipSuccess || per_cu < 1) fprintf(stderr, "occupancy query: %d\n", per_cu);
        (void)hipGetLastError();
        grid = cus;
        if (n_in != 23 || ws_size < WS_END) { fprintf(stderr, "kernel_launch: unexpected n_in %d / ws %zu\n", n_in, ws_size); }
    }
    if (grid < 0) return;
    (void)hipMemsetAsync((char*)d_ws + WS_CTL, 0, CTL_ZERO_BYTES, stream);
    Args a{};
    for (int i = 0; i < 23; ++i) a.in[i] = (const float*)d_in[i];
    a.out = (float*)d_out; a.ws = (uchar*)d_ws;
    uchar* ws = (uchar*)d_ws;
    a.flags = FAST_FLAGS;
    auto launch = [&](int lo, int hi) { a.ph_lo = lo; a.ph_hi = hi; hipLaunchKernelGGL(mk_fwd, dim3(grid), dim3(NTHR), LDS_BYTES, stream, a); };
#if FAST_FLAGS == 7 && DIFFTEST == 0 && !defined(MK_PER_PHASE)
    launch(PH_PRO, PH_N);
#else
    launch(PH_PRO, PH_PRO + 1);
    launch(PH_P1, PH_P1 + 1);
    {
        using namespace nv;
        float* dec = (float*)(ws + WS_XN);
#if DIFFTEST == 3
        (void)hipMemcpyAsync(ws + WS_DBG_A, ws + WS_GV, (size_t)128 * MiB, hipMemcpyDeviceToDevice, stream);
        k_gla_decay<<<(int)(((long)T * 2048 + 255) / 256), 256, 0, stream>>>((const bf16*)(ws + WS_GLRP), a.in[4], a.in[5], dec);
        k_gla_scan<<<dim3(8, 8, 2), 256, 0, stream>>>((const bf16*)(ws + WS_GQ), (const bf16*)(ws + WS_GK), (bf16*)(ws + WS_DBG_A), dec);
        k_gla_post<<<T * 8 / 4, 256, 0, stream>>>((bf16*)(ws + WS_DBG_A), (const bf16*)(ws + WS_GR), a.in[6]);
#endif
        if (!(FAST_FLAGS & 4)) {
        k_gla_decay<<<(int)(((long)T * 2048 + 255) / 256), 256, 0, stream>>>((const bf16*)(ws + WS_GLRP), a.in[4], a.in[5], dec);
        k_gla_scan<<<dim3(8, 8, 2), 256, 0, stream>>>((const bf16*)(ws + WS_GQ), (const bf16*)(ws + WS_GK), (bf16*)(ws + WS_GV), dec);
        k_gla_post<<<T * 8 / 4, 256, 0, stream>>>((bf16*)(ws + WS_GV), (const bf16*)(ws + WS_GR), a.in[6]);
        }
#if DIFFTEST == 2
        (void)hipMemcpyAsync(ws + WS_DBG_A, ws + WS_SQ, (size_t)128 * MiB, hipMemcpyDeviceToDevice, stream);
        (void)hipMemcpyAsync(ws + WS_DBG_B, ws + WS_SK, (size_t)16 * MiB, hipMemcpyDeviceToDevice, stream);
        k_headnorm<<<T * 64 / 4, 256, 0, stream>>>((bf16*)(ws + WS_DBG_A), 4096, 64, 64, a.in[7], T);
        k_headnorm<<<T * 8 / 4, 256, 0, stream>>>((bf16*)(ws + WS_DBG_B), 512, 8, 64, a.in[8], T);
        k_swa<<<T * 64 / 4, 256, 0, stream>>>((bf16*)(ws + WS_DBG_A), (const bf16*)(ws + WS_DBG_B), (const bf16*)(ws + WS_SV), a.in[9]);
#endif
        if (!(FAST_FLAGS & 2)) {
        k_headnorm<<<T * 64 / 4, 256, 0, stream>>>((bf16*)(ws + WS_SQ), 4096, 64, 64, a.in[7], T);
        k_headnorm<<<T * 8 / 4, 256, 0, stream>>>((bf16*)(ws + WS_SK), 512, 8, 64, a.in[8], T);
        k_swa<<<T * 64 / 4, 256, 0, stream>>>((bf16*)(ws + WS_SQ), (const bf16*)(ws + WS_SK), (const bf16*)(ws + WS_SV), a.in[9]);
        }
#if DIFFTEST == 1
        (void)hipMemcpyAsync(ws + WS_DBG_A, ws + WS_MQ, (size_t)128 * MiB, hipMemcpyDeviceToDevice, stream);
        (void)hipMemcpyAsync(ws + WS_DBG_B, ws + WS_KVM, (size_t)8 * MiB, hipMemcpyDeviceToDevice, stream);
        k_headnorm<<<512 * 4 / 4, 256, 0, stream>>>((bf16*)(ws + WS_DBG_B), 8192, 4, 1024, a.in[13], 512);
        k_headnorm<<<T * 4 / 4, 256, 0, stream>>>((bf16*)(ws + WS_DBG_A), 4096, 4, 1024, a.in[12], T);
        k_memattn<<<dim3(T / 8, 4), 256, 0, stream>>>((bf16*)(ws + WS_DBG_A), (const bf16*)(ws + WS_DBG_B));
#endif
        if (!(FAST_FLAGS & 1)) {
        k_headnorm<<<512 * 4 / 4, 256, 0, stream>>>((bf16*)(ws + WS_KVM), 8192, 4, 1024, a.in[13], 512);
        k_headnorm<<<T * 4 / 4, 256, 0, stream>>>((bf16*)(ws + WS_MQ), 4096, 4, 1024, a.in[12], T);
        k_memattn<<<dim3(T / 8, 4), 256, 0, stream>>>((bf16*)(ws + WS_MQ), (const bf16*)(ws + WS_KVM));
        }
    }
    launch(PH_PREP, PH_PREP + 1);
    launch(PH_MIX, PH_MIX + 1);
    launch(PH_MIX2, PH_MIX2 + 1);
#if DIFFTEST == 1
    dbg::k_diff<<<2048, 256, 0, stream>>>((const bf16*)(ws + WS_MQ), (const bf16*)(ws + WS_DBG_A), (size_t)T * 4096, (float*)(ws + WS_CTL) + 64);
#elif DIFFTEST == 2
    dbg::k_diff<<<2048, 256, 0, stream>>>((const bf16*)(ws + WS_SQ), (const bf16*)(ws + WS_DBG_A), (size_t)T * 4096, (float*)(ws + WS_CTL) + 64);
#elif DIFFTEST == 3
    dbg::k_diff<<<2048, 256, 0, stream>>>((const bf16*)(ws + WS_GV), (const bf16*)(ws + WS_DBG_A), (size_t)T * 4096, (float*)(ws + WS_CTL) + 64);
#endif
    launch(PH_MERGE, PH_MERGE + 1);
    launch(PH_WOUT, PH_WOUT + 1);
    launch(PH_HN, PH_HN + 1);
    launch(PH_PQ, PH_PQ + 1);
    launch(PH_TOPK, PH_TOPK + 1);
    launch(PH_PEER1, PH_PEER1 + 1);
    launch(PH_PEER2, PH_PEER2 + 1);
#endif
#if DIFFTEST
    dbg::k_scale<<<2048, 256, 0, stream>>>((float*)d_out, (size_t)T * 4096, (const float*)(ws + WS_CTL) + 64, 10.0f);
#endif
}
```

```cpp
#include <hip/hip_runtime.h>
#include <cstdio>
#include <cstdint>

#define GAS __attribute__((address_space(1)))
#define LAS __attribute__((address_space(3)))
typedef unsigned short bf16;
typedef unsigned v4u __attribute__((ext_vector_type(4)));
typedef unsigned v2u __attribute__((ext_vector_type(2)));
typedef float f32x4 __attribute__((ext_vector_type(4)));
typedef float f32x2 __attribute__((ext_vector_type(2)));
typedef short bf16x8 __attribute__((ext_vector_type(8)));
typedef unsigned char uchar;
typedef int v8i __attribute__((ext_vector_type(8)));
typedef int v4i __attribute__((ext_vector_type(4)));

#ifndef P1_NB16
#define P1_NB16 0
#endif
#ifndef FAST_FLAGS
#define FAST_FLAGS 7
#endif
constexpr int D = 4096, BATCH = 2, SEQ = 8192, T = BATCH * SEQ, MEM = 256;
constexpr int DIN = 33808;
constexpr int NV = 34048;
constexpr float EPS = 1e-6f;
constexpr int NWAVES = 8, NTHR = 512;

constexpr size_t MiB = 1u << 20;
constexpr size_t WS_CTL = 0, CTL_ZERO_BYTES = 1 * MiB;
constexpr size_t WS_WIN_T = 1 * MiB;
constexpr size_t WS_MIXF = WS_WIN_T;
constexpr size_t WS_WIN8 = WS_WIN_T + 96 * MiB;
constexpr size_t WS_WKV_T = WS_WIN_T + 266 * MiB;
constexpr size_t WS_WBR_T = WS_WKV_T + 64 * MiB;
constexpr size_t WS_WOUT_T = WS_WBR_T + 96 * MiB;
constexpr size_t WS_WQ_T = WS_WOUT_T + 32 * MiB;
constexpr size_t WS_U8 = WS_WIN_T;
constexpr size_t WS_V8T = WS_WIN_T + 64 * MiB;
constexpr size_t WS_HN8 = WS_WIN_T + 128 * MiB;
constexpr size_t WS_XN = WS_WQ_T + 16 * MiB;
constexpr size_t WS_MEMN = WS_XN + 128 * MiB;
constexpr size_t WS_KVM = WS_MEMN + 4 * MiB;
constexpr size_t WS_GQ = WS_KVM + 8 * MiB;
constexpr size_t WS_GK = WS_GQ + 64 * MiB;
constexpr size_t WS_QP = WS_GQ;
constexpr size_t WS_GV = WS_GK + 64 * MiB;
constexpr size_t WS_GR = WS_GV + 128 * MiB;
constexpr size_t WS_SQ = WS_GR + 128 * MiB;
constexpr size_t WS_SK = WS_SQ + 128 * MiB;
constexpr size_t WS_SV = WS_SK + 16 * MiB;
constexpr size_t WS_MQ = WS_SV + 16 * MiB;
constexpr size_t WS_GATE = WS_MQ + 128 * MiB;
constexpr size_t WS_GLRP = WS_GATE + 384 * MiB;
constexpr size_t WS_KD = WS_GLRP + 8 * MiB;
constexpr size_t WS_PC = WS_KD + 64 * MiB;
constexpr size_t WS_GAM = WS_PC + 16 * MiB;
constexpr size_t WS_PM = WS_GAM + 2 * MiB;
constexpr size_t WS_VTM = WS_PM + 32 * MiB;
constexpr size_t WS_RQ = WS_VTM + 4 * MiB;
constexpr size_t WS_QT = WS_RQ + 1 * MiB;
constexpr size_t WS_OA8 = WS_GK;
constexpr size_t WS_OB8 = WS_GQ;
constexpr size_t WS_OC8 = WS_QT;
constexpr size_t WS_HB = WS_SQ;
constexpr size_t WS_MIX8 = WS_XN;
constexpr size_t WS_XN8 = WS_QT;
constexpr size_t WS_END = WS_QT + 64 * MiB;
constexpr size_t WS_GA = WS_GV;
static_assert(WS_GA + (size_t)512 * MiB <= WS_GATE, "GA overlay");
constexpr size_t WS_A8 = WS_GATE;
static_assert(WS_END <= (size_t)2113 * MiB, "workspace");

constexpr int CW_TMO = 0, CW_BAR = 256;

constexpr int RING_BYTES = 131072;
constexpr int LDSCTL_OFF = RING_BYTES, MISC_OFF = LDSCTL_OFF + 320;
constexpr int LDS_BYTES = 147456;

#define RLX_AGENT __ATOMIC_RELAXED, __HIP_MEMORY_SCOPE_AGENT
#define LDS_WAIT() asm volatile("s_waitcnt lgkmcnt(0)" ::: "memory")
#define VM_WAIT() asm volatile("s_waitcnt vmcnt(0)" ::: "memory")
typedef __bf16 bf16x2_t __attribute__((ext_vector_type(2)));
__device__ __forceinline__ unsigned pk2(float lo, float hi) { const f32x2 v = {lo, hi}; return __builtin_bit_cast(unsigned, __builtin_convertvector(v, bf16x2_t)); }
__device__ __forceinline__ unsigned f2bf(float f) { return pk2(f, 0.f) & 0xffffu; }
__device__ __forceinline__ float bf2f(unsigned b) { return __builtin_bit_cast(float, b << 16); }
__device__ __forceinline__ float bflo(unsigned w) { return __builtin_bit_cast(float, w << 16); }
__device__ __forceinline__ float bfhi(unsigned w) { return __builtin_bit_cast(float, w & 0xffff0000u); }
__device__ __forceinline__ unsigned cvt_pk_bf16(float lo, float hi) { return pk2(lo, hi); }
__device__ __forceinline__ int lane_id() { return (int)__builtin_amdgcn_mbcnt_hi(~0u, __builtin_amdgcn_mbcnt_lo(~0u, 0u)); }
__device__ __forceinline__ int fresh_lane() { int l; asm volatile("v_mbcnt_lo_u32_b32 %0, -1, 0\n\tv_mbcnt_hi_u32_b32 %0, -1, %0" : "=v"(l)); return l; }
#define DPP_F(x, ctrl) __builtin_bit_cast(float, __builtin_amdgcn_update_dpp(0, __builtin_bit_cast(int, (x)), (ctrl), 0xF, 0xF, false))
#define RDL_F(x, l) __builtin_bit_cast(float, __builtin_amdgcn_readlane(__builtin_bit_cast(int, (x)), (l)))
__device__ __forceinline__ float wave_sum(float v) {
    v += DPP_F(v, 0xB1); v += DPP_F(v, 0x4E); v += DPP_F(v, 0x141); v += DPP_F(v, 0x140);
    return (RDL_F(v, 0) + RDL_F(v, 16)) + (RDL_F(v, 32) + RDL_F(v, 48));
}
__device__ __forceinline__ float wave_max(float v) {
    v = fmaxf(v, DPP_F(v, 0xB1)); v = fmaxf(v, DPP_F(v, 0x4E)); v = fmaxf(v, DPP_F(v, 0x141)); v = fmaxf(v, DPP_F(v, 0x140));
    return fmaxf(fmaxf(RDL_F(v, 0), RDL_F(v, 16)), fmaxf(RDL_F(v, 32), RDL_F(v, 48)));
}

#define XB_TMO      128
#define XB_XCNT(j)  (256  + 64 * (j))
#define XB_XSUB(j)  (1280 + 64 * (j))
#define XB_XGEN(j)  (2304 + 64 * (j))
#define XB_TOP      3328
#define XB_TOPGEN   3392
#define XCD_BAR_WORDS 3456
#define XB_SPIN_CAP (1u << 18)
__device__ __forceinline__ unsigned xb_ld(unsigned* p)              { return __hip_atomic_load(p, __ATOMIC_RELAXED, __HIP_MEMORY_SCOPE_AGENT); }
__device__ __forceinline__ unsigned xb_add(unsigned* p, unsigned v) { return __hip_atomic_fetch_add(p, v, __ATOMIC_RELAXED, __HIP_MEMORY_SCOPE_AGENT); }
__device__ __forceinline__ unsigned xb_xcc_id() { return (unsigned)__builtin_amdgcn_s_getreg((3 << 11) | 20) & 0xFu; }
#define XB_SPIN(cond, bar) do { unsigned _sp = 0; while (cond) { __builtin_amdgcn_s_sleep(1); \
    if ((++_sp & 255u) == 0u) { if (xb_ld(&(bar)[XB_TMO])) break; if (_sp > XB_SPIN_CAP) { atomicAdd(&(bar)[XB_TMO], 1u); break; } } } } while (0)
struct XcdBarrier { unsigned* bar; unsigned x; volatile LAS unsigned* st; };
__device__ __forceinline__ XcdBarrier xcd_barrier_post(unsigned* bar, volatile LAS unsigned* st) {
    XcdBarrier b; b.bar = bar; b.x = xb_xcc_id(); b.st = st;
    if (threadIdx.x == 0) (void)xb_add(&bar[XB_XCNT(b.x)], 1u);
    return b;
}
__device__ __forceinline__ void xcd_barrier_complete(unsigned* bar, unsigned x, unsigned& nloc, unsigned& nx) {
    const unsigned G = gridDim.x * gridDim.y * gridDim.z;
    unsigned sum, cnt, mine, sp = 0u;
    for (;;) {
        sum = 0u; cnt = 0u; mine = 0u;
#pragma unroll
        for (unsigned j = 0; j < 16; ++j) { const unsigned c = xb_ld(&bar[XB_XCNT(j)]); sum += c; cnt += (c > 0u) ? 1u : 0u; mine = (j == x) ? c : mine; }
        if (sum == G) break;
        __builtin_amdgcn_s_sleep(1);
        if ((++sp & 255u) == 0u) { if (xb_ld(&bar[XB_TMO])) break; if (sp > XB_SPIN_CAP) { atomicAdd(&bar[XB_TMO], 1u); break; } }
    }
    nloc = mine > 0u ? mine : 1u; nx = cnt > 0u ? cnt : 1u;
}
__device__ __forceinline__ void xcd_barrier(const XcdBarrier& b, int tid0) {
    asm volatile("s_waitcnt vmcnt(0)" ::: "memory");
    __syncthreads();
    if (tid0 == 0) {
        unsigned* bar = b.bar;
        __builtin_amdgcn_s_waitcnt(0);
        unsigned nloc = b.st[0], nx = b.st[1];
        if (nloc == 0u) { xcd_barrier_complete(bar, b.x, nloc, nx); b.st[0] = nloc; b.st[1] = nx; }
        const unsigned old = xb_add(&bar[XB_XSUB(b.x)], 1u);
        const unsigned gen = old / nloc;
        if (old + 1u == (gen + 1u) * nloc) {
            __builtin_amdgcn_fence(__ATOMIC_RELEASE, "agent");
            asm volatile("s_waitcnt vmcnt(0)" ::: "memory");
            const unsigned og = xb_add(&bar[XB_TOP], 1u);
            const unsigned tg = og / nx;
            if (og + 1u == (tg + 1u) * nx) xb_add(&bar[XB_TOPGEN], 1u);
            else XB_SPIN(xb_ld(&bar[XB_TOPGEN]) == tg, bar);
            __builtin_amdgcn_fence(__ATOMIC_ACQUIRE, "agent");
            xb_add(&bar[XB_XGEN(b.x)], 1u);
            asm volatile("s_waitcnt vmcnt(0)" ::: "memory");
        } else {
            XB_SPIN(xb_ld(&bar[XB_XGEN(b.x)]) == gen, bar);
            __builtin_amdgcn_fence(__ATOMIC_ACQUIRE, "agent");
            asm volatile("s_waitcnt vmcnt(0)" ::: "memory");
        }
    }
    __syncthreads();
}

namespace pg8 {
constexpr int BM = 256, BK = 64, HALF = 128, HTB = HALF * BK * 2, STAGE_BYTES = 8 * HTB, NXCD = 8, WGM = 8;
__host__ __device__ __forceinline__ int lds_byte(int r, int c) { const int st = (r >> 4) * 2 + (c >> 5), rr = r & 15, cc = c & 31, ob = rr * 64 + cc * 2; return st * 1024 + (ob ^ (((ob >> 9) & 1) << 5)); }
__host__ __device__ __forceinline__ void stage_rc(int b, int& R, int& C) { const int st = b / 1024, sb = b % 1024, swz = sb ^ (((sb >> 9) & 1) << 5); R = (st >> 1) * 16 + swz / 64; C = (st & 1) * 32 + (swz % 64) / 2; }
__host__ __device__ __forceinline__ int perm32(int rho) { const int n = rho >> 4, i = rho & 15; return 8 * (i >> 2) + 4 * n + (i & 3); }

struct GUnit { const char* A; const char* B; char* C; int ldc; int pm, pn, z; float scale; };
struct GemmG { int lda, ldb, K; };
__device__ __forceinline__ void tile_order(int L, int nM, int nN, int& pm, int& pn) {
    const int nwg = nM * nN; int wgid = L;
    { const int q = nwg / NXCD, r = nwg % NXCD, xcd = wgid % NXCD, off = wgid / NXCD; wgid = (xcd < r ? xcd * (q + 1) : r * (q + 1) + (xcd - r) * q) + off; }
    const int nig = WGM * nN, gid = wgid / nig, fm = gid * WGM, gsz = (nM - fm) < WGM ? (nM - fm) : WGM;
    pm = fm + ((wgid % nig) % gsz); pn = (wgid % nig) / gsz;
}

__device__ __forceinline__ void glds16s(const void* sbase, unsigned voff, unsigned lds_dst) { unsigned keep;
    asm volatile("s_mov_b32 %0, m0\n\ts_mov_b32 m0, %3\n\ts_nop 2\n\tglobal_load_lds_dwordx4 %1, %2\n\ts_mov_b32 m0, %0" : "=&s"(keep) : "v"(voff), "s"(sbase), "s"(lds_dst) : "memory"); }
template <class E, class = void> struct epi_chain { static constexpr bool v = false; };
template <class E> struct epi_chain<E, decltype((void)E::CHAIN)> { static constexpr bool v = E::CHAIN; };
template <class E, class = void> struct epi_bblk { static constexpr bool v = false; };
template <class E> struct epi_bblk<E, decltype((void)E::BBLK)> { static constexpr bool v = E::BBLK; };
template <class Epi, class Sched>
__device__ __forceinline__ void gemm_phase(LAS uchar* lds, const GemmG g, const Sched& S, const Epi& E, int wave_s) {
    constexpr bool BBLK = epi_bblk<Epi>::v;
    int tid_ = wave_s * 64 + fresh_lane();
    const int tid = tid_, wid = __builtin_amdgcn_readfirstlane(tid >> 6), lane = tid & 63, wr = wid >> 2, wc = wid & 3, fr = lane & 15, fq = lane >> 4;
    const int K = g.K, nt = K / BK;
    unsigned voffA[2], voffB[2];
#pragma unroll
    for (int i = 0; i < 2; ++i) { int R, C; stage_rc(tid * 16 + i * 8192, R, C); const int Rb = Epi::PERM ? ((R & ~31) + perm32(R & 31)) : R;
        voffA[i] = (unsigned)(R * g.lda + C) * 2u; voffB[i] = BBLK ? (unsigned)((C >> 5) * g.ldb + Rb * 64 + ((C * 2) & 63)) : (unsigned)(Rb * g.ldb + C) * 2u; }
    const size_t kstep = (size_t)(BK * 2), kstepB = BBLK ? (size_t)2 * g.ldb : (size_t)(BK * 2);
    const size_t hstepA = (size_t)HALF * g.lda * 2, hstepB = BBLK ? (size_t)HALF * 64 : (size_t)HALF * g.ldb * 2;
    const unsigned ldsw = (unsigned)wid * 1024u;
    const unsigned ldsb = (unsigned)__builtin_amdgcn_readfirstlane((int)((unsigned)(size_t)lds + ldsw));
    const int aoff = lds_byte(wr * 64 + fr, fq * 8), boff = lds_byte(wc * 32 + fr, fq * 8);
#define PG8_SA(b, h) (((b) * 2 + (h)) * HTB)
#define PG8_SB(b, h) ((4 + (b) * 2 + (h)) * HTB)
#define PG8_STAGE(bufoff, gbase, voff) do { _Pragma("unroll") for (int _i = 0; _i < 2; ++_i) \
        glds16s((const void*)(gbase), (voff)[_i], ldsb + (unsigned)((bufoff) + _i * 8192)); } while (0)
#define PG8_LDA(dst, b, h) do { if constexpr (Epi::FP8) { _Pragma("unroll") for (int m = 0; m < 4; ++m) dst##8[m] = __builtin_shufflevector(*(const LAS v4i*)(lds + PG8_SA(b, h) + aoff + m * 2048), *(const LAS v4i*)(lds + PG8_SA(b, h) + aoff + m * 2048 + 1024), 0, 1, 2, 3, 4, 5, 6, 7); } \
        else { _Pragma("unroll") for (int m = 0; m < 4; ++m) _Pragma("unroll") for (int k = 0; k < 2; ++k) dst[m][k] = *(const LAS bf16x8*)(lds + PG8_SA(b, h) + aoff + m * 2048 + k * 1024); } } while (0)
#define PG8_LDB(dst, b, h) do { if constexpr (Epi::FP8) { _Pragma("unroll") for (int n = 0; n < 2; ++n) dst##8[n] = __builtin_shufflevector(*(const LAS v4i*)(lds + PG8_SB(b, h) + boff + n * 2048), *(const LAS v4i*)(lds + PG8_SB(b, h) + boff + n * 2048 + 1024), 0, 1, 2, 3, 4, 5, 6, 7); } \
        else { _Pragma("unroll") for (int n = 0; n < 2; ++n) _Pragma("unroll") for (int k = 0; k < 2; ++k) dst[n][k] = *(const LAS bf16x8*)(lds + PG8_SB(b, h) + boff + n * 2048 + k * 1024); } } while (0)
#define PG8_CAT8(x, y) __builtin_shufflevector(__builtin_bit_cast(v4i, x), __builtin_bit_cast(v4i, y), 0, 1, 2, 3, 4, 5, 6, 7)
#define PG8_MMA(ai, bj, At, Bt) do { __builtin_amdgcn_s_setprio(1); \
        if constexpr (Epi::FP8) { _Pragma("unroll") for (int m = 0; m < 4; ++m) _Pragma("unroll") for (int n = 0; n < 2; ++n) \
            acc[ai][bj][m][n] = __builtin_amdgcn_mfma_scale_f32_16x16x128_f8f6f4(Bt##8[n], At##8[m], acc[ai][bj][m][n], 0, 0, 0, 127, 0, 127); } \
        else { _Pragma("unroll") for (int m = 0; m < 4; ++m) _Pragma("unroll") for (int n = 0; n < 2; ++n) _Pragma("unroll") for (int k = 0; k < 2; ++k) \
            acc[ai][bj][m][n] = __builtin_amdgcn_mfma_f32_16x16x32_bf16(Bt[n][k], At[m][k], acc[ai][bj][m][n], 0, 0, 0); } \
        __builtin_amdgcn_s_setprio(0); } while (0)
#define PG8_WAIT_V(n) asm volatile("s_waitcnt vmcnt(" #n ")" ::: "memory")
#define PG8_WAIT_L(n) asm volatile("s_waitcnt lgkmcnt(" #n ")" ::: "memory")
#define PG8_BAR __builtin_amdgcn_s_barrier()
#define PG8_SCHED __builtin_amdgcn_sched_barrier(0)
    GUnit cur, nxt; int ui = 0;
    if (!S.next(0, cur)) return;
    f32x4 acc[2][2][4][2];
#pragma unroll
    for (int a = 0; a < 2; ++a)
#pragma unroll
        for (int b = 0; b < 2; ++b)
#pragma unroll
            for (int m = 0; m < 4; ++m)
#pragma unroll
                for (int n = 0; n < 2; ++n) acc[a][b][m][n] = (f32x4){0.f, 0.f, 0.f, 0.f};
    bf16x8 At[4][2], B0[2][2], B1[2][2]; v8i At8[4], B08[2], B18[2];
    const char* cA = cur.A; const char* cB = cur.B;
    PG8_STAGE(PG8_SB(0, 0), cB, voffB); PG8_STAGE(PG8_SB(0, 1), cB + hstepB, voffB); PG8_STAGE(PG8_SA(0, 0), cA, voffA); PG8_STAGE(PG8_SA(0, 1), cA + hstepA, voffA);
    if (wr == 1) PG8_BAR;
    PG8_WAIT_V(2); PG8_BAR;
    PG8_STAGE(PG8_SB(1, 0), cB + kstepB, voffB); PG8_STAGE(PG8_SA(1, 0), cA + kstep, voffA); PG8_STAGE(PG8_SB(1, 1), cB + hstepB + kstepB, voffB);
    PG8_WAIT_V(6); PG8_BAR;
    for (;;) {
        const bool has_next = S.next(ui + 1, nxt);
        const char* nA = has_next ? nxt.A : cA; const char* nB = has_next ? nxt.B : cB;
        for (int t = 0; t < nt; t += 2) {
            const bool last = (t == nt - 2);
            const char* a1 = cA + (size_t)(t + 1) * kstep;
            const char* a2 = last ? nA : cA + (size_t)(t + 2) * kstep; const char* b2 = last ? nB : cB + (size_t)(t + 2) * kstepB;
            const char* a3 = a2 + kstep; const char* b3 = b2 + kstepB;
            PG8_LDB(B0, 0, 0); PG8_LDB(B1, 0, 1); PG8_SCHED; PG8_LDA(At, 0, 0); PG8_STAGE(PG8_SA(1, 1), a1 + hstepA, voffA);
            PG8_WAIT_V(8); PG8_WAIT_L(0); PG8_BAR; PG8_MMA(0, 0, At, B0); PG8_MMA(0, 1, At, B1); PG8_BAR; PG8_SCHED;
            PG8_LDA(At, 0, 1); PG8_STAGE(PG8_SB(0, 0), b2, voffB); PG8_STAGE(PG8_SB(0, 1), b2 + hstepB, voffB); PG8_STAGE(PG8_SA(0, 0), a2, voffA);
            PG8_WAIT_V(8); PG8_WAIT_L(0); PG8_BAR; PG8_MMA(1, 0, At, B0); PG8_MMA(1, 1, At, B1); PG8_BAR; PG8_SCHED;
            PG8_LDB(B0, 1, 0); PG8_LDB(B1, 1, 1); PG8_SCHED; PG8_LDA(At, 1, 0); PG8_STAGE(PG8_SA(0, 1), a2 + hstepA, voffA);
            PG8_WAIT_V(8); PG8_WAIT_L(0); PG8_BAR; PG8_MMA(0, 0, At, B0); PG8_MMA(0, 1, At, B1); PG8_BAR; PG8_SCHED;
            PG8_LDA(At, 1, 1); PG8_STAGE(PG8_SB(1, 0), b3, voffB); PG8_STAGE(PG8_SB(1, 1), b3 + hstepB, voffB); PG8_STAGE(PG8_SA(1, 0), a3, voffA);
            PG8_WAIT_V(8); PG8_WAIT_L(0); PG8_BAR; PG8_MMA(1, 0, At, B0); PG8_MMA(1, 1, At, B1); PG8_BAR; PG8_SCHED;
        }
        if (wr == 0) PG8_BAR;
        E(acc, cur, wr, wc, fr, fq);
        if (!has_next) break;
        if (!epi_chain<Epi>::v || cur.z == 2) {
#pragma unroll
        for (int a = 0; a < 2; ++a)
#pragma unroll
            for (int b = 0; b < 2; ++b)
#pragma unroll
                for (int m = 0; m < 4; ++m)
#pragma unroll
                    for (int n = 0; n < 2; ++n) acc[a][b][m][n] = (f32x4){0.f, 0.f, 0.f, 0.f};
        }
        cur = nxt; cA = nA; cB = nB; ++ui;
        if (wr == 1) PG8_BAR;
    }
    PG8_WAIT_V(0);
    PG8_BAR;
#undef PG8_SA
#undef PG8_SB
#undef PG8_STAGE
#undef PG8_LDA
#undef PG8_LDB
#undef PG8_MMA
#undef PG8_CAT8
#undef PG8_WAIT_V
#undef PG8_WAIT_L
#undef PG8_BAR
#undef PG8_SCHED
}

__device__ __forceinline__ unsigned pk4_fp8(float a, float b, float c, float d) {
    a = fminf(fmaxf(a, -448.f), 448.f); b = fminf(fmaxf(b, -448.f), 448.f); c = fminf(fmaxf(c, -448.f), 448.f); d = fminf(fmaxf(d, -448.f), 448.f);
    int r = 0; r = __builtin_amdgcn_cvt_pk_fp8_f32(a, b, r, false); r = __builtin_amdgcn_cvt_pk_fp8_f32(c, d, r, true); return (unsigned)r;
}
template <bool F8> struct EpiBf16T {
    static constexpr bool FP8 = F8; static constexpr bool PERM = true;
    __device__ __forceinline__ void operator()(const f32x4 (&acc)[2][2][4][2], const GUnit& u, int wr, int wc, int fr, int fq) const {
        const int l_ = fresh_lane(); fr = l_ & 15; fq = l_ >> 4;
        bf16* base = (bf16*)u.C + (size_t)(wr * 64 + fr) * u.ldc + wc * 32 + 8 * fq; const float s = u.scale;
        if (u.z == 2) {
            bf16* fb = (bf16*)u.C + (wr * 4 + wc) * 8192 + l_ * 8;
#pragma unroll
            for (int ai = 0; ai < 2; ++ai)
#pragma unroll
                for (int m = 0; m < 4; ++m) { bf16* rowp = fb + ((ai * 4 + m) * 2) * 512;
#pragma unroll
                    for (int bj = 0; bj < 2; ++bj) { f32x4 v0 = acc[ai][bj][m][0] * s, v1 = acc[ai][bj][m][1] * s;
#pragma unroll
                        for (int j = 0; j < 4; ++j) { v0[j] = 1.0f + __expf(-fminf(fmaxf(v0[j], -30.f), 30.f)); v1[j] = 1.0f + __expf(-fminf(fmaxf(v1[j], -30.f), 30.f)); }
                        v4u w; w.x = cvt_pk_bf16(v0[0], v0[1]); w.y = cvt_pk_bf16(v0[2], v0[3]); w.z = cvt_pk_bf16(v1[0], v1[1]); w.w = cvt_pk_bf16(v1[2], v1[3]);
                        *(v4u*)(rowp + bj * 512) = w; } }
        } else {
#pragma unroll
        for (int ai = 0; ai < 2; ++ai)
#pragma unroll
            for (int m = 0; m < 4; ++m) { bf16* rowp = base + (size_t)(ai * HALF + m * 16) * u.ldc;
#pragma unroll
                for (int bj = 0; bj < 2; ++bj) { const f32x4 v0 = acc[ai][bj][m][0] * s, v1 = acc[ai][bj][m][1] * s;
                    v4u w; w.x = cvt_pk_bf16(v0[0], v0[1]); w.y = cvt_pk_bf16(v0[2], v0[3]); w.z = cvt_pk_bf16(v1[0], v1[1]); w.w = cvt_pk_bf16(v1[2], v1[3]);
                    *(v4u*)(rowp + bj * HALF) = w; } }
        }
    }
};
typedef EpiBf16T<false> EpiBf16;
template <bool F8> struct EpiF32T {
    static constexpr bool FP8 = F8; static constexpr bool PERM = false;
    const float* R;
    __device__ __forceinline__ void operator()(const f32x4 (&acc)[2][2][4][2], const GUnit& u, int wr, int wc, int fr, int fq) const {
        const int l_ = fresh_lane(); fr = l_ & 15; fq = l_ >> 4;
        float* base = (float*)u.C + (size_t)(wr * 64 + fr) * u.ldc + wc * 32 + 4 * fq; const float sc = u.scale;
        const float* rb = R ? R + ((size_t)u.pm * BM + wr * 64 + fr) * u.ldc + (size_t)u.pn * BM + wc * 32 + 4 * fq : nullptr;
#pragma unroll
        for (int ai = 0; ai < 2; ++ai) {
            f32x4 rv[4][2][2];
#pragma unroll
            for (int m = 0; m < 4; ++m)
#pragma unroll
                for (int bj = 0; bj < 2; ++bj)
#pragma unroll
                    for (int n = 0; n < 2; ++n) rv[m][bj][n] = rb ? *(const f32x4*)(rb + (size_t)(ai * HALF + m * 16) * u.ldc + bj * HALF + n * 16) : (f32x4){0.f, 0.f, 0.f, 0.f};
#pragma unroll
            for (int m = 0; m < 4; ++m) { const size_t ro = (size_t)(ai * HALF + m * 16) * u.ldc;
#pragma unroll
                for (int bj = 0; bj < 2; ++bj)
#pragma unroll
                    for (int n = 0; n < 2; ++n) *(f32x4*)(base + ro + bj * HALF + n * 16) = acc[ai][bj][m][n] * sc + rv[m][bj][n]; } }
    }
};
typedef EpiF32T<false> EpiF32;
struct EpiOutFp8 {
    static constexpr bool FP8 = false; static constexpr bool PERM = true;
    __device__ __forceinline__ void operator()(const f32x4 (&acc)[2][2][4][2], const GUnit& u, int wr, int wc, int fr, int fq) const {
        const int l_ = fresh_lane(); fr = l_ & 15; fq = l_ >> 4;
        uchar* base = (uchar*)u.C + (size_t)(wr * 64 + fr) * u.ldc + wc * 32 + 8 * fq; const float s = u.scale;
#pragma unroll
        for (int ai = 0; ai < 2; ++ai)
#pragma unroll
            for (int m = 0; m < 4; ++m) { uchar* rowp = base + (size_t)(ai * HALF + m * 16) * u.ldc;
#pragma unroll
                for (int bj = 0; bj < 2; ++bj) { const f32x4 v0 = acc[ai][bj][m][0] * s, v1 = acc[ai][bj][m][1] * s;
                    v2u w; w.x = pk4_fp8(v0[0], v0[1], v0[2], v0[3]); w.y = pk4_fp8(v1[0], v1[1], v1[2], v1[3]); *(v2u*)(rowp + bj * HALF) = w; } }
    }
};
struct EpiMerge {
    static constexpr bool FP8 = true; static constexpr bool PERM = true; static constexpr bool CHAIN = true;
    const bf16* gate; uchar* mix8;
    __device__ __forceinline__ void operator()(f32x4 (&acc)[2][2][4][2], const GUnit& u, int wr, int wc, int fr, int fq) const {
        const int l_ = fresh_lane(); fr = l_ & 15; fq = l_ >> 4;
        const size_t row0 = (size_t)u.pm * BM + wr * 64 + fr; const int col0 = u.pn * BM + wc * 32 + 8 * fq; const int z = u.z;
        const bool fin = z == 2; const float f0 = z == 0 ? 2.f : 1.f, f2 = u.scale * 32.f; const int zn = fin ? 2 : z + 1;
#pragma unroll
        for (int aq = 0; aq < 4; ++aq) { const int ai = aq >> 1, m0 = (aq & 1) * 2;
            asm volatile("" ::: "memory");
            v4u ga[4][2], gb[4][2];
#pragma unroll
            for (int m = m0; m < m0 + 2; ++m)
#pragma unroll
                for (int bj = 0; bj < 2; ++bj) { const size_t fo = (size_t)(((wr * 4 + wc) * 2 + ai) * 4 + m) * 1024 + bj * 512 + l_ * 8;
                    ga[m][bj] = __builtin_nontemporal_load((const v4u*)(gate + ((size_t)u.pm * 48 + z * 16 + u.pn) * 65536 + fo)); gb[m][bj] = *(const v4u*)(gate + ((size_t)u.pm * 48 + zn * 16 + u.pn) * 65536 + fo); }
#pragma unroll
            for (int m = m0; m < m0 + 2; ++m)
#pragma unroll
                for (int bj = 0; bj < 2; ++bj) { const v4u a4 = ga[m][bj], b4 = gb[m][bj];
                    const float gl[8] = {bflo(a4.x), bfhi(a4.x), bflo(a4.y), bfhi(a4.y), bflo(a4.z), bfhi(a4.z), bflo(a4.w), bfhi(a4.w)};
                    const float gn[8] = {bflo(b4.x), bfhi(b4.x), bflo(b4.y), bfhi(b4.y), bflo(b4.z), bfhi(b4.z), bflo(b4.w), bfhi(b4.w)};
#pragma unroll
                    for (int j = 0; j < 8; ++j) acc[ai][bj][m][j >> 2][j & 3] *= (fin ? f2 : f0 * gn[j]) * __builtin_amdgcn_rcpf(gl[j]); }
        }
        if (fin) {
#pragma unroll
            for (int ai = 0; ai < 2; ++ai)
#pragma unroll
                for (int m = 0; m < 4; ++m)
#pragma unroll
                    for (int bj = 0; bj < 2; ++bj) { const size_t row = row0 + ai * HALF + m * 16; const int col = col0 + bj * HALF; const f32x4 v0 = acc[ai][bj][m][0], v1 = acc[ai][bj][m][1];
                        v2u w; w.x = pk4_fp8(v0[0], v0[1], v0[2], v0[3]); w.y = pk4_fp8(v1[0], v1[1], v1[2], v1[3]);
                        *(v2u*)(mix8 + row * 4096 + col) = w; }
        }
    }
};

__device__ __forceinline__ f32x2 gelu_pk(f32x2 v) {
    const f32x2 av = __builtin_elementwise_abs(v), d = av * 0.2316418882f + 1.0f;
    f32x2 t; t.x = __builtin_amdgcn_rcpf(d.x); t.y = __builtin_amdgcn_rcpf(d.y);
    f32x2 q = t * 0.5307027145f + (-0.7265760135f); q = q * t + 0.7107068705f; q = q * t + (-0.142248368f); q = q * t + 0.127414796f; q = q * t;
    const f32x2 s = (v * v) * (-0.72134752044f);
    f32x2 e; e.x = __builtin_amdgcn_exp2f(s.x); e.y = __builtin_amdgcn_exp2f(s.y);
    const f32x2 m = v * (q * e), r = v - m;
    f32x2 o; o.x = v.x < 0.f ? m.x : r.x; o.y = v.y < 0.f ? m.y : r.y; return o;
}
struct EpiPeerA8 {
    static constexpr bool FP8 = true; static constexpr bool PERM = true;
    const uchar* g; uchar* a8;
    __device__ __forceinline__ void operator()(const f32x4 (&acc)[2][2][4][2], const GUnit& u, int wr, int wc, int fr, int fq) const {
        const int l_ = fresh_lane(); fr = l_ & 15; fq = l_ >> 4;
        const size_t row0 = (size_t)u.pm * BM + wr * 64 + fr; const int col0 = u.pn * BM + wc * 32 + 8 * fq;
        v2u gws[2][4][2];
#pragma unroll
        for (int ai = 0; ai < 2; ++ai)
#pragma unroll
            for (int m = 0; m < 4; ++m)
#pragma unroll
                for (int bj = 0; bj < 2; ++bj) gws[ai][m][bj] = *(const v2u*)(g + (row0 + ai * HALF + m * 16) * 16384 + col0 + bj * HALF);
#pragma unroll
        for (int ai = 0; ai < 2; ++ai)
#pragma unroll
            for (int m = 0; m < 4; ++m) { const size_t row = row0 + ai * HALF + m * 16;
#pragma unroll
                for (int bj = 0; bj < 2; ++bj) { const size_t off = row * 16384 + col0 + bj * HALF;
                    const v2u gw = gws[ai][m][bj]; v2u w = {0u, 0u};
                    if ((gw.x | gw.y) != 0u) {
                        const f32x4 v0 = acc[ai][bj][m][0] * 0.000244140625f, v1 = acc[ai][bj][m][1] * 0.000244140625f;
                        const f32x2 a = gelu_pk((f32x2){v0[0], v0[1]}), b = gelu_pk((f32x2){v0[2], v0[3]}), c = gelu_pk((f32x2){v1[0], v1[1]}), d = gelu_pk((f32x2){v1[2], v1[3]});
                        const f32x2 g0 = __builtin_amdgcn_cvt_pk_f32_fp8((int)gw.x, false), g1 = __builtin_amdgcn_cvt_pk_f32_fp8((int)gw.x, true), g2 = __builtin_amdgcn_cvt_pk_f32_fp8((int)gw.y, false), g3 = __builtin_amdgcn_cvt_pk_f32_fp8((int)gw.y, true);
                        w.x = pk4_fp8(a.x * g0.x, a.y * g0.y, b.x * g1.x, b.y * g1.y);
                        w.y = pk4_fp8(c.x * g2.x, c.y * g2.y, d.x * g3.x, d.y * g3.y); }
                    *(v2u*)(a8 + off) = w; } }
    }
};
}

struct Ptrs {
    const float* in[23]; float* out; uchar* ws;
};
struct SchedP1 {
    uchar* ws; int G, c; bool f8;
    __device__ __forceinline__ bool next(int i, pg8::GUnit& u) const {
        const int L = i * G + c; const int nN = f8 ? 133 - P1_NB16 : P1_NB16; const int NREG = 64 * nN;
        if (L >= NREG + (f8 ? 64 : 0)) return false;
        const size_t ESZ = f8 ? 1 : 2; const float S0 = f8 ? 0.000244140625f : 1.f;
        u.scale = S0; u.z = 0;
        if (L < NREG) {
            int pm, pn; pg8::tile_order(L, 64, nN, pm, pn); if (f8) pn += P1_NB16; u.pm = pm; u.pn = pn;
            u.A = (const char*)(ws + (f8 ? WS_XN8 : WS_XN)) + (size_t)pm * 256 * D * ESZ; u.B = (const char*)(ws + (f8 ? WS_WIN8 : WS_WIN_T)) + (size_t)pn * 256 * D * ESZ;
            size_t base; int ldc, ct;
            if (pn < 8) { base = WS_GQ; ldc = 2048; ct = pn; u.scale = 0.0625f * S0; }
            else if (pn < 24) { base = WS_GR; ldc = 4096; ct = pn - 8; }
            else if (pn < 32) { base = WS_GK; ldc = 2048; ct = pn - 24; }
            else if (pn < 48) { base = WS_GV; ldc = 4096; ct = pn - 32; }
            else if (pn < 64) { base = WS_SQ; ldc = 4096; ct = pn - 48; }
            else if (pn < 66) { base = WS_SK; ldc = 512; ct = pn - 64; }
            else if (pn < 68) { base = WS_SV; ldc = 512; ct = pn - 66; }
            else if (pn < 84) { base = WS_MQ; ldc = 4096; ct = pn - 68; }
            else if (pn < 132) { base = WS_GATE; ldc = 12288; ct = pn - 84; u.z = 2; }
            else { base = WS_GLRP; ldc = 256; ct = 0; }
            u.ldc = ldc; u.C = (char*)(ws + base) + ((size_t)pm * 256 * ldc + (size_t)ct * 256) * 2;
            if (u.z == 2) u.C = (char*)(ws + WS_GATE) + ((size_t)pm * 48 + ct) * 131072;
        } else {
            const int j = L - NREG, pm = j >> 5, pn = j & 31; u.pm = pm; u.pn = pn; u.z = 1;
            u.A = (const char*)(ws + WS_MEMN) + (size_t)pm * 256 * D; u.B = (const char*)(ws + WS_WKV_T) + (size_t)pn * 256 * D;
            u.ldc = 8192; u.C = (char*)(ws + WS_KVM) + ((size_t)pm * 256 * 8192 + (size_t)pn * 256) * 2;
        }
        return true;
    }
};
struct SchedMerge {
    uchar* ws; int G, c;
    __device__ __forceinline__ bool next(int i, pg8::GUnit& u) const {
        const int r = i / 3, z = i - 3 * r, L = r * G + c;
        if (L >= 64 * 16) return false;
        int pm, pn; pg8::tile_order(L, 64, 16, pm, pn); u.pm = pm; u.pn = pn; u.z = z; u.ldc = 4096; u.C = nullptr;
        u.scale = z == 0 ? 0.0001220703125f : 0.00006103515625f;
        const size_t ab = z == 0 ? WS_OA8 : (z == 1 ? WS_OB8 : WS_OC8);
        u.A = (const char*)(ws + ab) + (size_t)pm * 256 * D; u.B = (const char*)(ws + WS_WBR_T) + ((size_t)z * 4096 + (size_t)pn * 256) * D;
        return true;
    }
};
struct SchedPlain {
    const char* A; const char* B; char* C; int nM, nN, K, esz, G, c; float scale;
    __device__ __forceinline__ bool next(int i, pg8::GUnit& u) const {
        const int L = i * G + c; if (L >= nM * nN) return false;
        int pm, pn; pg8::tile_order(L, nM, nN, pm, pn); u.pm = pm; u.pn = pn; u.z = 0; u.scale = scale; u.ldc = nN * 256;
        u.A = A + (size_t)pm * 256 * K * 2; u.B = B + (size_t)pn * 256 * K * 2; u.C = C + ((size_t)pm * 256 * u.ldc + (size_t)pn * 256) * esz;
        return true;
    }
};

struct EpiWoutHB {
    static constexpr bool FP8 = true; static constexpr bool PERM = true;
    const float* X; bf16* HB;
    __device__ __forceinline__ void operator()(const f32x4 (&acc)[2][2][4][2], const pg8::GUnit& u, int wr, int wc, int fr, int fq) const {
        constexpr int HALF = pg8::HALF;
        const int l_ = fresh_lane(); fr = l_ & 15; fq = l_ >> 4;
        const size_t e0 = ((size_t)u.pm * 256 + wr * 64 + fr) * 4096 + (size_t)u.pn * 256 + wc * 32 + 8 * fq; const float sc = u.scale;
#pragma unroll
        for (int ai = 0; ai < 2; ++ai) {
            f32x4 rv[4][2][2];
#pragma unroll
            for (int m = 0; m < 4; ++m)
#pragma unroll
                for (int bj = 0; bj < 2; ++bj)
#pragma unroll
                    for (int n = 0; n < 2; ++n) rv[m][bj][n] = *(const f32x4*)(X + e0 + (size_t)(ai * HALF + m * 16) * 4096 + bj * HALF + n * 4);
#pragma unroll
            for (int m = 0; m < 4; ++m)
#pragma unroll
                for (int bj = 0; bj < 2; ++bj) { const f32x4 v0 = acc[ai][bj][m][0] * sc + rv[m][bj][0], v1 = acc[ai][bj][m][1] * sc + rv[m][bj][1];
                    v4u w; w.x = pk2(v0[0], v0[1]); w.y = pk2(v0[2], v0[3]); w.z = pk2(v1[0], v1[1]); w.w = pk2(v1[2], v1[3]);
                    *(v4u*)(HB + e0 + (size_t)(ai * HALF + m * 16) * 4096 + bj * HALF) = w; } }
    }
};
struct EpiPeer2 {
    static constexpr bool FP8 = true; static constexpr bool PERM = true; static constexpr bool BBLK = true;
    const bf16* HB; float* O;
    __device__ __forceinline__ void operator()(const f32x4 (&acc)[2][2][4][2], const pg8::GUnit& u, int wr, int wc, int fr, int fq) const {
        constexpr int HALF = pg8::HALF;
        const int l_ = fresh_lane(); fr = l_ & 15; fq = l_ >> 4;
        const size_t e0 = ((size_t)u.pm * 256 + wr * 64 + fr) * 4096 + (size_t)u.pn * 256 + wc * 32 + 8 * fq; const float sc = u.scale;
#pragma unroll
        for (int ai = 0; ai < 2; ++ai) {
            v4u rv[4][2];
#pragma unroll
            for (int m = 0; m < 4; ++m)
#pragma unroll
                for (int bj = 0; bj < 2; ++bj) rv[m][bj] = *(const v4u*)(HB + e0 + (size_t)(ai * HALF + m * 16) * 4096 + bj * HALF);
#pragma unroll
            for (int m = 0; m < 4; ++m)
#pragma unroll
                for (int bj = 0; bj < 2; ++bj) { const v4u r_ = rv[m][bj]; float* op = O + e0 + (size_t)(ai * HALF + m * 16) * 4096 + bj * HALF;
                    f32x4 v0 = acc[ai][bj][m][0] * sc, v1 = acc[ai][bj][m][1] * sc;
                    v0[0] += bflo(r_.x); v0[1] += bfhi(r_.x); v0[2] += bflo(r_.y); v0[3] += bfhi(r_.y); v1[0] += bflo(r_.z); v1[1] += bfhi(r_.z); v1[2] += bflo(r_.w); v1[3] += bfhi(r_.w);
                    *(f32x4*)op = v0; *(f32x4*)(op + 4) = v1; } }
    }
};
struct SchedPeer2 {
    const char* A; const char* B; char* C; int G, c; float scale;
    __device__ __forceinline__ bool next(int i, pg8::GUnit& u) const {
        const int L = i * G + c; if (L >= 64 * 16) return false;
        int pm, pn; pg8::tile_order(L, 64, 16, pm, pn); u.pm = pm; u.pn = pn; u.z = 0; u.scale = scale; u.ldc = 4096;
        u.A = A + (size_t)pm * 256 * 16384; u.B = B + (size_t)pn * 256 * 64; u.C = C + ((size_t)pm * 256 * 4096 + (size_t)pn * 256) * 4;
        return true;
    }
};

struct SchedMemS {
    uchar* ws; int G, c;
    __device__ __forceinline__ bool next(int i, pg8::GUnit& u) const {
        const int L = i * G + c; if (L >= 256) return false;
        const int pm = L >> 2, h = L & 3, b = pm >> 5; u.pm = pm; u.pn = 0; u.z = h; u.scale = 1.f; u.ldc = 0; u.C = nullptr;
        u.A = (const char*)(ws + WS_MQ) + ((size_t)pm * 256 * 4096 + (size_t)h * 1024) * 2; u.B = (const char*)(ws + WS_KVM) + ((size_t)b * 256 * 8192 + (size_t)h * 1024) * 2;
        return true;
    }
};
struct SchedMemO {
    uchar* ws; int G, c;
    __device__ __forceinline__ bool next(int i, pg8::GUnit& u) const {
        const int L = i * G + c; if (L >= 1024) return false;
        const int pm = L >> 4, h = (L >> 2) & 3, pn = L & 3, b = pm >> 5; u.pm = pm; u.pn = pn; u.z = h; u.scale = 32.f; u.ldc = 4096;
        u.A = (const char*)(ws + WS_PM) + ((size_t)pm * 256 * 1024 + (size_t)h * 256) * 2; u.B = (const char*)(ws + WS_VTM) + ((size_t)(b * 4096 + h * 1024 + pn * 256) * 256) * 2;
        u.C = (char*)(ws + WS_OC8) + ((size_t)pm * 256 * 4096 + (size_t)h * 1024 + (size_t)pn * 256);
        return true;
    }
};
namespace pg8 {
struct EpiMemS {
    static constexpr bool FP8 = false; static constexpr bool PERM = true;
    const float* rq; bf16* pmat; LAS float* part;
    __device__ __forceinline__ void operator()(f32x4 (&acc)[2][2][4][2], const GUnit& u, int wr, int wc, int fr, int fq) const {
        const int h = u.z;
#pragma unroll
        for (int ai = 0; ai < 2; ++ai)
#pragma unroll
            for (int m = 0; m < 4; ++m) { const int row = ai * HALF + wr * 64 + m * 16 + fr; const float sc = rq[((size_t)u.pm * BM + row) * 4 + h] * 1.44269504f; float s = 0.f;
#pragma unroll
                for (int bj = 0; bj < 2; ++bj)
#pragma unroll
                    for (int n = 0; n < 2; ++n) { f32x4 v = acc[ai][bj][m][n] * sc;
#pragma unroll
                        for (int j = 0; j < 4; ++j) { v[j] = __builtin_amdgcn_exp2f(v[j]); s += v[j]; }
                        acc[ai][bj][m][n] = v; }
                s += __shfl_xor(s, 16); s += __shfl_xor(s, 32);
                if (fq == 0) part[row * 4 + wc] = s; }
        asm volatile("s_waitcnt lgkmcnt(0)" ::: "memory"); __builtin_amdgcn_s_barrier(); asm volatile("" ::: "memory");
#pragma unroll
        for (int ai = 0; ai < 2; ++ai)
#pragma unroll
            for (int m = 0; m < 4; ++m) { int row = ai * HALF + wr * 64 + m * 16 + fr; asm volatile("" : "+v"(row)); const f32x4 pp = *(const LAS f32x4*)(part + row * 4); const float inv = 1.0f / ((pp.x + pp.y) + (pp.z + pp.w));
                bf16* rowp = pmat + ((size_t)u.pm * BM + row) * 1024 + h * 256 + wc * 32 + 8 * fq;
#pragma unroll
                for (int bj = 0; bj < 2; ++bj) { const f32x4 v0 = acc[ai][bj][m][0] * inv, v1 = acc[ai][bj][m][1] * inv;
                    v4u w; w.x = cvt_pk_bf16(v0[0], v0[1]); w.y = cvt_pk_bf16(v0[2], v0[3]); w.z = cvt_pk_bf16(v1[0], v1[1]); w.w = cvt_pk_bf16(v1[2], v1[3]);
                    *(v4u*)(rowp + bj * HALF) = w; } }
        asm volatile("s_waitcnt lgkmcnt(0)" ::: "memory"); __builtin_amdgcn_s_barrier(); asm volatile("" ::: "memory");
    }
};
}

constexpr int SWA_KP = 144, SWA_VP = 528;
constexpr int SWA_KOFF = 0, SWA_VOFF = 256 * SWA_KP;
__device__ __forceinline__ void swa_unit(LAS uchar* lds, const bf16* sq, const bf16* sk, const bf16* sv, uchar* ob8, const float* gq, const float* gk, const float* sinks, int b, int blk, int kvh, int tid) {
    const int lane = tid & 63, wave = __builtin_amdgcn_readfirstlane(tid >> 6);
    const long tq0 = (long)b * SEQ + (long)blk * 128, tk0 = tq0 - 128;
#pragma unroll
    for (int r = 0; r < 4; ++r) {
        const int idx = tid + 512 * r, key = idx >> 3, ch = idx & 7;
        v4u kw = {0u, 0u, 0u, 0u}, vw = {0u, 0u, 0u, 0u};
        if (blk > 0 || key >= 128) { kw = *(const GAS v4u*)(sk + (tk0 + key) * 512 + kvh * 64 + ch * 8); vw = *(const GAS v4u*)(sv + (tk0 + key) * 512 + kvh * 64 + ch * 8); }
        float kf[8] = {bflo(kw.x), bfhi(kw.x), bflo(kw.y), bfhi(kw.y), bflo(kw.z), bfhi(kw.z), bflo(kw.w), bfhi(kw.w)};
        float ss = 0.f;
#pragma unroll
        for (int i = 0; i < 8; ++i) ss += kf[i] * kf[i];
        ss += __shfl_xor(ss, 1); ss += __shfl_xor(ss, 2); ss += __shfl_xor(ss, 4);
        const float rr = rsqrtf(ss * (1.f / 64.f) + EPS);
        const f32x4 g0 = *(const GAS f32x4*)(gk + ch * 8), g1 = *(const GAS f32x4*)(gk + ch * 8 + 4);
        v4u o; o.x = pk2(kf[0] * rr * g0.x, kf[1] * rr * g0.y); o.y = pk2(kf[2] * rr * g0.z, kf[3] * rr * g0.w); o.z = pk2(kf[4] * rr * g1.x, kf[5] * rr * g1.y); o.w = pk2(kf[6] * rr * g1.z, kf[7] * rr * g1.w);
        *(LAS v4u*)(lds + SWA_KOFF + key * SWA_KP + ch * 16) = o;
        const unsigned vv[4] = {vw.x, vw.y, vw.z, vw.w};
#pragma unroll
        for (int i = 0; i < 4; ++i) { *(LAS unsigned short*)(lds + SWA_VOFF + (ch * 8 + 2 * i) * SWA_VP + key * 2) = (unsigned short)(vv[i] & 0xffffu);
                                      *(LAS unsigned short*)(lds + SWA_VOFF + (ch * 8 + 2 * i + 1) * SWA_VP + key * 2) = (unsigned short)(vv[i] >> 16); }
    }
    LDS_WAIT(); __syncthreads();
    const int g = wave, hq = kvh * 8 + g, r16 = lane & 15, g4 = lane >> 4;
    const float sink = sinks[hq];
    const f32x4 gqa = *(const GAS f32x4*)(gq + 8 * g4), gqb = *(const GAS f32x4*)(gq + 8 * g4 + 4), gqc = *(const GAS f32x4*)(gq + 32 + 8 * g4), gqd = *(const GAS f32x4*)(gq + 32 + 8 * g4 + 4);
    for (int ti = 0; ti < 8; ++ti) {
        const bf16* qp = sq + (tq0 + 16 * ti + r16) * 4096 + hq * 64;
        const v4u q0 = *(const GAS v4u*)(qp + 8 * g4), q1 = *(const GAS v4u*)(qp + 32 + 8 * g4);
        float qa[8] = {bflo(q0.x), bfhi(q0.x), bflo(q0.y), bfhi(q0.y), bflo(q0.z), bfhi(q0.z), bflo(q0.w), bfhi(q0.w)};
        float qb[8] = {bflo(q1.x), bfhi(q1.x), bflo(q1.y), bfhi(q1.y), bflo(q1.z), bfhi(q1.z), bflo(q1.w), bfhi(q1.w)};
        float ss = 0.f;
#pragma unroll
        for (int i = 0; i < 8; ++i) ss += qa[i] * qa[i] + qb[i] * qb[i];
        ss += __shfl_xor(ss, 16); ss += __shfl_xor(ss, 32);
        const float rq = rsqrtf(ss * (1.f / 64.f) + EPS) * 0.125f;
        v4u qw0, qw1;
        qw0.x = pk2(qa[0] * rq * gqa.x, qa[1] * rq * gqa.y); qw0.y = pk2(qa[2] * rq * gqa.z, qa[3] * rq * gqa.w); qw0.z = pk2(qa[4] * rq * gqb.x, qa[5] * rq * gqb.y); qw0.w = pk2(qa[6] * rq * gqb.z, qa[7] * rq * gqb.w);
        qw1.x = pk2(qb[0] * rq * gqc.x, qb[1] * rq * gqc.y); qw1.y = pk2(qb[2] * rq * gqc.z, qb[3] * rq * gqc.w); qw1.z = pk2(qb[4] * rq * gqd.x, qb[5] * rq * gqd.y); qw1.w = pk2(qb[6] * rq * gqd.z, qb[7] * rq * gqd.w);
        const bf16x8 qf0 = __builtin_bit_cast(bf16x8, qw0), qf1 = __builtin_bit_cast(bf16x8, qw1);
        f32x4 st[9];
#pragma unroll
        for (int c = 0; c < 9; ++c) {
            const LAS uchar* kp = lds + SWA_KOFF + (16 * (ti + c) + r16) * SWA_KP + 16 * g4;
            const bf16x8 k0 = *(const LAS bf16x8*)kp, k1 = *(const LAS bf16x8*)(kp + 64);
            f32x4 a = {0.f, 0.f, 0.f, 0.f};
            a = __builtin_amdgcn_mfma_f32_16x16x32_bf16(k0, qf0, a, 0, 0, 0);
            a = __builtin_amdgcn_mfma_f32_16x16x32_bf16(k1, qf1, a, 0, 0, 0);
            st[c] = a;
        }
        float mx = -INFINITY;
#pragma unroll
        for (int c = 0; c < 9; ++c)
#pragma unroll
            for (int i = 0; i < 4; ++i) { const int dlt = 16 * c + 4 * g4 + i - r16; const bool ok = (dlt >= 1) && (dlt <= 128) && (blk > 0 || (16 * (ti + c) + 4 * g4 + i) >= 128);
                st[c][i] = ok ? st[c][i] : -INFINITY; mx = fmaxf(mx, st[c][i]); }
        mx = fmaxf(mx, __shfl_xor(mx, 16)); mx = fmaxf(mx, __shfl_xor(mx, 32)); mx = fmaxf(mx, sink);
        float sum = 0.f;
#pragma unroll
        for (int c = 0; c < 9; ++c)
#pragma unroll
            for (int i = 0; i < 4; ++i) { const float p = __expf(st[c][i] - mx); st[c][i] = p; sum += p; }
        sum += __shfl_xor(sum, 16); sum += __shfl_xor(sum, 32);
        const float inv = 1.0f / (sum + __expf(sink - mx));
        f32x4 ot[4];
#pragma unroll
        for (int dt = 0; dt < 4; ++dt) ot[dt] = (f32x4){0.f, 0.f, 0.f, 0.f};
#pragma unroll
        for (int kk = 0; kk < 5; ++kk) {
            v4u pw; pw.x = pk2(st[2 * kk][0] * inv, st[2 * kk][1] * inv); pw.y = pk2(st[2 * kk][2] * inv, st[2 * kk][3] * inv);
            if (kk < 4) { pw.z = pk2(st[2 * kk + 1][0] * inv, st[2 * kk + 1][1] * inv); pw.w = pk2(st[2 * kk + 1][2] * inv, st[2 * kk + 1][3] * inv); } else { pw.z = 0u; pw.w = 0u; }
            const bf16x8 pf = __builtin_bit_cast(bf16x8, pw);
            const int t0 = ti + 2 * kk, t1 = (ti + 2 * kk + 1) > 15 ? 15 : (ti + 2 * kk + 1);
#pragma unroll
            for (int dt = 0; dt < 4; ++dt) {
                const LAS uchar* vp = lds + SWA_VOFF + (16 * dt + r16) * SWA_VP + 8 * g4;
                const v2u va = *(const LAS v2u*)(vp + 32 * t0), vb = *(const LAS v2u*)(vp + 32 * t1);
                v4u vw; vw.x = va.x; vw.y = va.y; vw.z = vb.x; vw.w = vb.y;
                ot[dt] = __builtin_amdgcn_mfma_f32_16x16x32_bf16(__builtin_bit_cast(bf16x8, vw), pf, ot[dt], 0, 0, 0);
            }
        }
#pragma unroll
        for (int dt = 0; dt < 4; ++dt) *(GAS unsigned*)(ob8 + (tq0 + 16 * ti + r16) * 4096 + hq * 64 + 16 * dt + 4 * g4) = pg8::pk4_fp8(32.f * ot[dt][0], 32.f * ot[dt][1], 32.f * ot[dt][2], 32.f * ot[dt][3]);
    }
    __syncthreads();
}

__device__ __forceinline__ void gla_prep_item(LAS uchar* lds, uchar* ws, const float* wup, const float* bias, int it, int tid) {
    const int h = it & 7; const long t0 = (long)(it >> 3) * 64;
    const int d = tid & 255, half = tid >> 8, lane = tid & 63, wave = __builtin_amdgcn_readfirstlane(tid >> 6), r16 = lane & 15, g4 = lane >> 4;
    LAS float* glr_s = (LAS float*)lds; LAS float* tot_s = (LAS float*)(lds + 4096); LAS float* bl_s = (LAS float*)(lds + 5120);
    LAS uchar* Qs = lds + 8192; LAS uchar* Ks = Qs + 33792; LAS uchar* Kd = Ks + 33792;
    const bf16* gq = (const bf16*)(ws + WS_GQ); const bf16* gk = (const bf16*)(ws + WS_GK); const bf16* glrp = (const bf16*)(ws + WS_GLRP);
#pragma unroll
    for (int r = 0; r < 4; ++r) { const int ch = tid + 512 * r, row = ch >> 5, c8 = ch & 31; const size_t go = (size_t)(t0 + row) * 2048 + h * 256 + c8 * 8;
        *(LAS v4u*)(Qs + row * 528 + c8 * 16) = *(const GAS v4u*)(gq + go); *(LAS v4u*)(Ks + row * 528 + c8 * 16) = *(const GAS v4u*)(gk + go); }
#pragma unroll
    for (int r = 0; r < 2; ++r) { const int idx = tid + 512 * r; glr_s[idx] = bf2f(glrp[(t0 + (idx >> 4)) * 256 + (idx & 15)]); }
    float wu[16];
#pragma unroll
    for (int r = 0; r < 16; ++r) wu[r] = wup[r * 2048 + h * 256 + d];
    const float bs = bias[h * 256 + d];
    LDS_WAIT(); __syncthreads();
    float bc[32]; float run = 0.f;
#pragma unroll
    for (int ii = 0; ii < 32; ++ii) { const int i = 32 * half + ii; float s = bs;
#pragma unroll
        for (int r4 = 0; r4 < 4; ++r4) { const f32x4 gv = *(const LAS f32x4*)(glr_s + i * 16 + 4 * r4); s += gv.x * wu[4 * r4] + gv.y * wu[4 * r4 + 1] + gv.z * wu[4 * r4 + 2] + gv.w * wu[4 * r4 + 3]; }
        const float ls = (fminf(s, 0.f) - __logf(1.0f + __expf(-fabsf(s)))) * 0.0625f; run += ls; bc[ii] = run; }
    if (half == 0) tot_s[d] = run;
    LDS_WAIT(); __syncthreads();
    const float off = half ? tot_s[d] : 0.f;
    if (half == 1) bl_s[d] = run + off;
    LDS_WAIT(); __syncthreads();
    const float bl = bl_s[d]; const float gam = __expf(bl);
#pragma unroll 8
    for (int ii = 0; ii < 32; ++ii) { const int i = 32 * half + ii; const float b = bc[ii] + off; const float E = __expf(b), Ei = __builtin_amdgcn_rcpf(E), Ed = gam * Ei;
        LAS unsigned short* qp_ = (LAS unsigned short*)(Qs + i * 528 + d * 2); LAS unsigned short* kp_ = (LAS unsigned short*)(Ks + i * 528 + d * 2);
        const float q = bf2f(*qp_), k = bf2f(*kp_);
        *qp_ = (unsigned short)f2bf(q * E); *kp_ = (unsigned short)f2bf(k * Ei); *(LAS unsigned short*)(Kd + i * 528 + d * 2) = (unsigned short)f2bf(k * Ed); }
    if (half == 0) ((float*)(ws + WS_GAM))[(size_t)it * 256 + d] = gam;
    LDS_WAIT(); __syncthreads();
#pragma unroll
    for (int r = 0; r < 4; ++r) { const int ch = tid + 512 * r, fl = ch & 63, fr_ = fl & 15, fg = fl >> 4, ks = (ch >> 6) & 7, tt = ch >> 9;
        *(GAS v4u*)((bf16*)(ws + WS_QT) + (size_t)it * 16384 + (size_t)ch * 8) = *(const LAS v4u*)(Qs + (16 * tt + fr_) * 528 + (32 * ks + 8 * fg) * 2); }
#pragma unroll
    for (int r = 0; r < 4; ++r) { const int ch = tid + 512 * r, fl = ch & 63, fr_ = fl & 15, fg = fl >> 4, ks = (ch >> 6) & 1, tt = ch >> 7;
        const LAS uchar* kp_ = Kd + (32 * ks + 8 * fg) * 528 + (16 * tt + fr_) * 2; unsigned short x_[8];
#pragma unroll
        for (int jj = 0; jj < 8; ++jj) x_[jj] = *(const LAS unsigned short*)(kp_ + jj * 528);
        v4u w_; w_.x = x_[0] | ((unsigned)x_[1] << 16); w_.y = x_[2] | ((unsigned)x_[3] << 16); w_.z = x_[4] | ((unsigned)x_[5] << 16); w_.w = x_[6] | ((unsigned)x_[7] << 16);
        *(GAS v4u*)((bf16*)(ws + WS_KD) + (size_t)it * 16384 + (size_t)ch * 8) = w_; }
    const int ti = wave >> 1;
    LAS uchar* Ps = Kd + 33792;
#pragma unroll
    for (int tjj = 0; tjj < 2; ++tjj) { const int tj = 2 * (wave & 1) + tjj; f32x4 acc = {0.f, 0.f, 0.f, 0.f};
        if (tj <= ti) {
#pragma unroll
            for (int ks = 0; ks < 8; ++ks) { const bf16x8 a = *(const LAS bf16x8*)(Qs + (16 * ti + r16) * 528 + (32 * ks + 8 * g4) * 2), bb = *(const LAS bf16x8*)(Ks + (16 * tj + r16) * 528 + (32 * ks + 8 * g4) * 2);
                acc = __builtin_amdgcn_mfma_f32_16x16x32_bf16(a, bb, acc, 0, 0, 0); } }
#pragma unroll
        for (int ii = 0; ii < 4; ++ii) { const int i = 16 * ti + 4 * g4 + ii, j = 16 * tj + r16; *(LAS unsigned short*)(Ps + i * 144 + j * 2) = (unsigned short)f2bf(j <= i ? acc[ii] : 0.f); } }
    LDS_WAIT(); __syncthreads();
    { const int ch = tid, fl = ch & 63, fr_ = fl & 15, fg = fl >> 4, ks = (ch >> 6) & 1, tt = ch >> 7;
      *(GAS v4u*)((bf16*)(ws + WS_PC) + (size_t)it * 4096 + (size_t)ch * 8) = *(const LAS v4u*)(Ps + (16 * tt + fr_) * 144 + (32 * ks + 8 * fg) * 2); }
    __syncthreads();
}
__device__ __forceinline__ void gla_scan_unit(LAS uchar* lds, uchar* ws, int u, int tid) {
    const int bh = u >> 4, sl = u & 15, b = bh >> 3, h = bh & 7;
    const int lane = tid & 63, wave = __builtin_amdgcn_readfirstlane(tid >> 6), r16 = lane & 15, g4 = lane >> 4;
    LAS uchar* Sb = lds; LAS uchar* VT = lds + 2 * 16896;
    for (int i = tid; i < 16896 / 16; i += NTHR) *(LAS v4u*)(Sb + i * 16) = (v4u){0u, 0u, 0u, 0u};
    const long it0 = ((long)b * 128) * 8 + h, tb = (long)b * SEQ;
    constexpr int UN = 8;
    if (wave < 4) {
        const int ti = wave, vj = tid >> 2, vec = tid & 3;
        const bf16* pq = (const bf16*)(ws + WS_QT) + it0 * 16384 + (ti * 8) * 512 + lane * 8;
        const bf16* pp = (const bf16*)(ws + WS_PC) + it0 * 4096 + (ti * 2) * 512 + lane * 8;
        const bf16* pv = (const bf16*)(ws + WS_GV) + (tb + vj) * 4096 + h * 512 + 32 * sl + vec * 8;
        bf16* po = (bf16*)(ws + WS_GV) + (tb + 16 * ti + (lane >> 2)) * 4096 + h * 512 + 32 * sl + (lane & 3) * 8;
        LAS uchar* ot = lds + 43008 + wave * 1280;
#define GO_LOAD(Q, P, c) do { const size_t c_ = (size_t)(c); \
            _Pragma("unroll") for (int ks = 0; ks < 8; ++ks) Q[ks] = *(const GAS bf16x8*)(pq + c_ * (8 * 16384) + 512 * ks); \
            _Pragma("unroll") for (int ks = 0; ks < 2; ++ks) P[ks] = *(const GAS bf16x8*)(pp + c_ * (8 * 4096) + 512 * ks); } while (0)
#define GO_VLOAD(V, c) do { const int cc_ = (c) < 128 ? (c) : 127; V = *(const GAS v4u*)(pv + (size_t)cc_ * (64 * 4096)); } while (0)
#define GO_VSTAGE(V, buf) do { const unsigned vv_[4] = {V.x, V.y, V.z, V.w}; LAS uchar* vt_ = VT + (buf) * 4608; \
            _Pragma("unroll") for (int i = 0; i < 4; ++i) { *(LAS unsigned short*)(vt_ + (vec * 8 + 2 * i) * 144 + vj * 2) = (unsigned short)(vv_[i] & 0xffffu); *(LAS unsigned short*)(vt_ + (vec * 8 + 2 * i + 1) * 144 + vj * 2) = (unsigned short)(vv_[i] >> 16); } } while (0)
        { v4u v0_; GO_VLOAD(v0_, 0); GO_VSTAGE(v0_, 0); }
        LDS_WAIT(); __builtin_amdgcn_s_barrier(); asm volatile("" ::: "memory");
        for (int c0 = 0; c0 < 128; c0 += UN) {
            bf16x8 q[3][8], p[3][2]; v4u vr[3];
#pragma unroll
            for (int s3 = 0; s3 < 3; ++s3) GO_LOAD(q[s3], p[s3], c0 + s3);
            GO_VLOAD(vr[1], c0 + 1); GO_VLOAD(vr[2], c0 + 2);
#pragma unroll
            for (int st = 0; st < UN; ++st) {
                const int c = c0 + st;
                const LAS uchar* sb_ = Sb + (c & 1) * 16896; const LAS uchar* vt_r = VT + (c & 1) * 4608;
                f32x4 o0 = {0.f, 0.f, 0.f, 0.f}, o1 = {0.f, 0.f, 0.f, 0.f};
#pragma unroll
                for (int ks = 0; ks < 8; ++ks) { const bf16x8 s0 = *(const LAS bf16x8*)(sb_ + r16 * 528 + (32 * ks + 8 * g4) * 2), s1 = *(const LAS bf16x8*)(sb_ + (16 + r16) * 528 + (32 * ks + 8 * g4) * 2);
                    o0 = __builtin_amdgcn_mfma_f32_16x16x32_bf16(q[st % 3][ks], s0, o0, 0, 0, 0); o1 = __builtin_amdgcn_mfma_f32_16x16x32_bf16(q[st % 3][ks], s1, o1, 0, 0, 0); }
#pragma unroll
                for (int ks = 0; ks < 2; ++ks) { const bf16x8 v0 = *(const LAS bf16x8*)(vt_r + r16 * 144 + (32 * ks + 8 * g4) * 2), v1 = *(const LAS bf16x8*)(vt_r + (16 + r16) * 144 + (32 * ks + 8 * g4) * 2);
                    o0 = __builtin_amdgcn_mfma_f32_16x16x32_bf16(p[st % 3][ks], v0, o0, 0, 0, 0); o1 = __builtin_amdgcn_mfma_f32_16x16x32_bf16(p[st % 3][ks], v1, o1, 0, 0, 0); }
#pragma unroll
                for (int ii = 0; ii < 4; ++ii) { *(LAS unsigned short*)(ot + (4 * g4 + ii) * 80 + r16 * 2) = (unsigned short)f2bf(o0[ii]); *(LAS unsigned short*)(ot + (4 * g4 + ii) * 80 + 32 + r16 * 2) = (unsigned short)f2bf(o1[ii]); }
                LDS_WAIT();
                { const v4u ow_ = *(const LAS v4u*)(ot + (lane >> 2) * 80 + (lane & 3) * 16); *(GAS v4u*)(po + (size_t)c * (64 * 4096)) = ow_; }
                if (st + 3 < UN) GO_LOAD(q[st % 3], p[st % 3], c + 3);
                GO_VSTAGE(vr[(st + 1) % 3], (c + 1) & 1);
                if (st + 2 < UN) GO_VLOAD(vr[st % 3], c + 3);
                LDS_WAIT(); __builtin_amdgcn_s_barrier(); asm volatile("" ::: "memory");
            }
        }
#undef GO_LOAD
#undef GO_VLOAD
#undef GO_VSTAGE
    } else {
        const int wq = wave - 4;
        const bf16* pk = (const bf16*)(ws + WS_KD) + it0 * 16384 + (4 * wq * 2) * 512 + lane * 8;
        const float* pg = (const float*)(ws + WS_GAM) + it0 * 256 + 64 * wq + 4 * g4;
        f32x4 accS[4][2];
#pragma unroll
        for (int a = 0; a < 4; ++a) { accS[a][0] = (f32x4){0.f, 0.f, 0.f, 0.f}; accS[a][1] = (f32x4){0.f, 0.f, 0.f, 0.f}; }
#define GS_LOAD(K, Gm, c) do { const size_t c_ = (size_t)(c); \
            _Pragma("unroll") for (int td = 0; td < 4; ++td) { _Pragma("unroll") for (int ks = 0; ks < 2; ++ks) K[td][ks] = *(const GAS bf16x8*)(pk + c_ * (8 * 16384) + td * 1024 + 512 * ks); \
                Gm[td] = *(const GAS f32x4*)(pg + c_ * (8 * 256) + td * 16); } } while (0)
        LDS_WAIT(); __builtin_amdgcn_s_barrier(); asm volatile("" ::: "memory");
        for (int c0 = 0; c0 < 128; c0 += UN) {
            bf16x8 kk[3][4][2]; f32x4 gg[3][4];
#pragma unroll
            for (int s3 = 0; s3 < 3; ++s3) GS_LOAD(kk[s3], gg[s3], c0 + s3);
#pragma unroll
            for (int st = 0; st < UN; ++st) {
                const int c = c0 + st;
                const LAS uchar* vt_r = VT + (c & 1) * 4608; LAS uchar* sbn_ = Sb + ((c + 1) & 1) * 16896;
                bf16x8 vf_[2][2];
#pragma unroll
                for (int t2 = 0; t2 < 2; ++t2)
#pragma unroll
                    for (int ks = 0; ks < 2; ++ks) vf_[t2][ks] = *(const LAS bf16x8*)(vt_r + (16 * t2 + r16) * 144 + (32 * ks + 8 * g4) * 2);
#pragma unroll
                for (int td = 0; td < 4; ++td)
#pragma unroll
                    for (int t2 = 0; t2 < 2; ++t2) { f32x4 a_ = accS[td][t2] * gg[st % 3][td];
#pragma unroll
                        for (int ks = 0; ks < 2; ++ks) a_ = __builtin_amdgcn_mfma_f32_16x16x32_bf16(kk[st % 3][td][ks], vf_[t2][ks], a_, 0, 0, 0);
                        accS[td][t2] = a_; v2u w_; w_.x = pk2(a_[0], a_[1]); w_.y = pk2(a_[2], a_[3]);
                        *(LAS v2u*)(sbn_ + (16 * t2 + r16) * 528 + (64 * wq + 16 * td + 4 * g4) * 2) = w_; }
                if (st + 3 < UN) GS_LOAD(kk[st % 3], gg[st % 3], c + 3);
                LDS_WAIT(); __builtin_amdgcn_s_barrier(); asm volatile("" ::: "memory");
            }
        }
#undef GS_LOAD
    }
    VM_WAIT(); __syncthreads();
}
template <int NB> __device__ __forceinline__ void gla_post_items(uchar* ws, const float* gain, int it, int stride, int lane) {
    const int h = it & 7; v4u ow[NB], gw[NB]; size_t off[NB];
#pragma unroll
    for (int b = 0; b < NB; ++b) { const int itb = (it + b * stride < T * 8) ? it + b * stride : it;
        off[b] = (size_t)(itb >> 3) * 4096 + h * 512 + lane * 8; ow[b] = *(const GAS v4u*)((const bf16*)(ws + WS_GV) + off[b]); gw[b] = *(const GAS v4u*)((const bf16*)(ws + WS_GR) + off[b]); }
    const f32x4 g0 = *(const GAS f32x4*)(gain + h * 512 + lane * 8), g1 = *(const GAS f32x4*)(gain + h * 512 + lane * 8 + 4);
    const float gn[8] = {g0.x, g0.y, g0.z, g0.w, g1.x, g1.y, g1.z, g1.w};
#pragma unroll
    for (int b = 0; b < NB; ++b) {
        float o[8] = {bflo(ow[b].x), bfhi(ow[b].x), bflo(ow[b].y), bfhi(ow[b].y), bflo(ow[b].z), bfhi(ow[b].z), bflo(ow[b].w), bfhi(ow[b].w)};
        const float gr[8] = {bflo(gw[b].x), bfhi(gw[b].x), bflo(gw[b].y), bfhi(gw[b].y), bflo(gw[b].z), bfhi(gw[b].z), bflo(gw[b].w), bfhi(gw[b].w)};
        float ss = 0.f;
#pragma unroll
        for (int i = 0; i < 8; ++i) ss += o[i] * o[i];
        const float rr = rsqrtf(wave_sum(ss) * (1.f / 512.f) + EPS);
#pragma unroll
        for (int i = 0; i < 8; ++i) o[i] = o[i] * rr * gn[i] * (gr[i] * __builtin_amdgcn_rcpf(1.f + __expf(-gr[i])));
        v2u w; w.x = pg8::pk4_fp8(16.f * o[0], 16.f * o[1], 16.f * o[2], 16.f * o[3]); w.y = pg8::pk4_fp8(16.f * o[4], 16.f * o[5], 16.f * o[6], 16.f * o[7]);
        *(GAS v2u*)(ws + WS_OA8 + off[b]) = w; }
}

__device__ __forceinline__ void transpose_item(const float* W, int ldw, int K, bf16* WT, int k0, int nsrc0, int ndst0, int ncols, LAS float* scr, int lane) {
    { float t_[32];
#pragma unroll
      for (int i = 0; i < 32; ++i) { const int kk = 2 * i + (lane >> 5), n = lane & 31; t_[i] = (n < ncols) ? W[(size_t)(k0 + kk) * ldw + nsrc0 + n] : 0.f; }
#pragma unroll
      for (int i = 0; i < 32; ++i) scr[(2 * i + (lane >> 5)) * 33 + (lane & 31)] = t_[i]; }
    LDS_WAIT(); asm volatile("" ::: "memory");
    const int c = lane & 7;
#pragma unroll
    for (int j = 0; j < 4; ++j) { const int n = (lane >> 3) + 8 * j; const LAS float* s = scr + (8 * c) * 33 + n;
        v4u o; o.x = pk2(s[0 * 33], s[1 * 33]); o.y = pk2(s[2 * 33], s[3 * 33]); o.z = pk2(s[4 * 33], s[5 * 33]); o.w = pk2(s[6 * 33], s[7 * 33]);
        if (n < ncols) *(GAS v4u*)(WT + (size_t)(ndst0 + n) * K + k0 + 8 * c) = o; }
    LDS_WAIT(); asm volatile("" ::: "memory");
}
__device__ __forceinline__ void transpose_item8(const float* W, int ldw, int K, uchar* WT8, int k0, int nsrc0, int ndst0, int ncols, float scale, LAS float* scr, int lane) {
    { float t_[32];
#pragma unroll
      for (int i = 0; i < 32; ++i) { const int kk = 2 * i + (lane >> 5), n = lane & 31; t_[i] = (n < ncols) ? W[(size_t)(k0 + kk) * ldw + nsrc0 + n] : 0.f; }
#pragma unroll
      for (int i = 0; i < 32; ++i) scr[(2 * i + (lane >> 5)) * 33 + (lane & 31)] = t_[i] * scale; }
    LDS_WAIT(); asm volatile("" ::: "memory");
    { const int n = lane & 31, hf = lane >> 5; const LAS float* sp = scr + (32 * hf) * 33 + n; unsigned w[8];
#pragma unroll
      for (int q = 0; q < 8; ++q) w[q] = pg8::pk4_fp8(sp[(4 * q) * 33], sp[(4 * q + 1) * 33], sp[(4 * q + 2) * 33], sp[(4 * q + 3) * 33]);
      if (n < ncols) { GAS v4u* dst = (GAS v4u*)(WT8 + (size_t)(ndst0 + n) * K + k0 + 32 * hf); dst[0] = (v4u){w[0], w[1], w[2], w[3]}; dst[1] = (v4u){w[4], w[5], w[6], w[7]}; } }
    LDS_WAIT(); asm volatile("" ::: "memory");
}
__device__ __forceinline__ void rms_row_to_bf16(const float* xrow, const float* gain, bf16* orow, int lane, uchar* o8row = nullptr) {
    const GAS f32x4* xr = (const GAS f32x4*)xrow + lane; const GAS f32x4* gr = (const GAS f32x4*)gain + lane;
    float s = 0.f;
#pragma unroll
    for (int j = 0; j < 16; ++j) { const f32x4 v = xr[64 * j]; s += (v.x * v.x + v.y * v.y) + (v.z * v.z + v.w * v.w); }
    const float r = rsqrtf(wave_sum(s) * (1.f / 4096.f) + EPS);
    GAS v2u* o8 = (GAS v2u*)orow + lane;
#pragma unroll
    for (int j = 0; j < 16; ++j) { const f32x4 v = xr[64 * j], g = gr[64 * j]; const float y0 = v.x * r * g.x, y1 = v.y * r * g.y, y2 = v.z * r * g.z, y3 = v.w * r * g.w; if (orow) { v2u w; w.x = pk2(y0, y1); w.y = pk2(y2, y3); o8[64 * j] = w; }
        if (o8row) ((GAS unsigned*)o8row)[lane + 64 * j] = pg8::pk4_fp8(8.f * y0, 8.f * y1, 8.f * y2, 8.f * y3); }
}
__device__ __forceinline__ void rms_rowb_to_bf16(const bf16* xrow, const float* gain, bf16* orow, int lane, uchar* o8row) {
    const GAS v4u* xr = (const GAS v4u*)xrow + lane; const GAS f32x4* gr = (const GAS f32x4*)gain + lane * 2;
    v4u xv[8]; float s = 0.f;
#pragma unroll
    for (int j = 0; j < 8; ++j) xv[j] = xr[64 * j];
#pragma unroll
    for (int j = 0; j < 8; ++j) { const v4u a = xv[j]; const float e[8] = {bflo(a.x), bfhi(a.x), bflo(a.y), bfhi(a.y), bflo(a.z), bfhi(a.z), bflo(a.w), bfhi(a.w)};
#pragma unroll
        for (int i = 0; i < 8; ++i) s += e[i] * e[i]; }
    const float r = rsqrtf(wave_sum(s) * (1.f / 4096.f) + EPS);
#pragma unroll
    for (int j = 0; j < 8; ++j) { const v4u a = xv[j]; const f32x4 g0 = gr[128 * j], g1 = gr[128 * j + 1];
        const float y0 = bflo(a.x) * r * g0.x, y1 = bfhi(a.x) * r * g0.y, y2 = bflo(a.y) * r * g0.z, y3 = bfhi(a.y) * r * g0.w, y4 = bflo(a.z) * r * g1.x, y5 = bfhi(a.z) * r * g1.y, y6 = bflo(a.w) * r * g1.z, y7 = bfhi(a.w) * r * g1.w;
        v4u w; w.x = pk2(y0, y1); w.y = pk2(y2, y3); w.z = pk2(y4, y5); w.w = pk2(y6, y7); ((GAS v4u*)orow)[lane + 64 * j] = w;
        v2u w8; w8.x = pg8::pk4_fp8(8.f * y0, 8.f * y1, 8.f * y2, 8.f * y3); w8.y = pg8::pk4_fp8(8.f * y4, 8.f * y5, 8.f * y6, 8.f * y7); ((GAS v2u*)o8row)[lane + 64 * j] = w8; }
}

template <int NV> __device__ __forceinline__ void select16(const float (&v)[NV], bool (&sel)[NV], int lane) {
    float mx = v[0], mn = v[0];
#pragma unroll
    for (int r = 1; r < NV; ++r) { mx = fmaxf(mx, v[r]); mn = fminf(mn, v[r]); }
    mx = wave_max(mx); mn = -wave_max(-mn);
    float lo = mn - 1.0f, hi = mx; bool done = false;
    for (int it = 0; it < 36; ++it) {
        const float mid = 0.5f * (lo + hi); int c = 0;
#pragma unroll
        for (int r = 0; r < NV; ++r) c += __popcll(__ballot(v[r] > mid));
        if (c == 16) {
#pragma unroll
            for (int r = 0; r < NV; ++r) sel[r] = v[r] > mid;
            done = true; break; }
        if (c > 16) lo = mid; else hi = mid;
    }
    if (!done) {
        unsigned k[NV];
#pragma unroll
        for (int r = 0; r < NV; ++r) { unsigned x = __builtin_bit_cast(unsigned, v[r]); x ^= (x >> 31) ? 0xFFFFFFFFu : 0x80000000u; k[r] = x; }
        unsigned th = 0u;
        for (int bit = 31; bit >= 0; --bit) { const unsigned cand = th | (1u << bit); int c = 0;
#pragma unroll
            for (int r = 0; r < NV; ++r) c += __popcll(__ballot(k[r] >= cand));
            if (c >= 16) th = cand; }
        int need = 16;
#pragma unroll
        for (int r = 0; r < NV; ++r) need -= __popcll(__ballot(k[r] > th));
        const unsigned long long ltmask = (1ull << lane) - 1ull; int before = 0;
#pragma unroll
        for (int r = 0; r < NV; ++r) { const unsigned long long eq = __ballot(k[r] == th); sel[r] = (k[r] > th) || (k[r] == th && (before + __popcll(eq & ltmask)) < need); before += __popcll(eq); }
    }
}

__device__ __forceinline__ void select16_pair(const float (&a)[2], const float (&b)[2], bool (&sa)[2], bool (&sb)[2], int lane) {
    float amx = wave_max(fmaxf(a[0], a[1])), amn = -wave_max(-fminf(a[0], a[1])), bmx = wave_max(fmaxf(b[0], b[1])), bmn = -wave_max(-fminf(b[0], b[1]));
    float alo = amn - 1.0f, ahi = amx, blo = bmn - 1.0f, bhi = bmx, apiv = 0.f, bpiv = 0.f; bool ad = false, bd = false;
    for (int it = 0; it < 36 && !(ad && bd); ++it) {
        const float am = 0.5f * (alo + ahi), bm = 0.5f * (blo + bhi);
        const int ca = __popcll(__ballot(a[0] > am)) + __popcll(__ballot(a[1] > am)), cb = __popcll(__ballot(b[0] > bm)) + __popcll(__ballot(b[1] > bm));
        if (!ad) { if (ca == 16) { ad = true; apiv = am; } else if (ca > 16) alo = am; else ahi = am; }
        if (!bd) { if (cb == 16) { bd = true; bpiv = bm; } else if (cb > 16) blo = bm; else bhi = bm; }
    }
    if (ad) { sa[0] = a[0] > apiv; sa[1] = a[1] > apiv; } else select16<2>(a, sa, lane);
    if (bd) { sb[0] = b[0] > bpiv; sb[1] = b[1] > bpiv; } else select16<2>(b, sb, lane);
}

struct Args { const float* in[23]; float* out; uchar* ws; int ph_lo, ph_hi, flags, pad; };
#ifndef STAG_MERGE
#define STAG_MERGE 0
#endif
#ifndef STAG_P1
#define STAG_P1 0
#endif
#ifndef STAG_WOUT
#define STAG_WOUT 0
#endif
#ifndef STAG_PEER1
#define STAG_PEER1 0
#endif
#ifndef STAG_PEER2
#define STAG_PEER2 0
#endif
__device__ __forceinline__ void stagger_wait(unsigned ticks) {
    if (ticks) { const unsigned long long t0 = __builtin_amdgcn_s_memrealtime(); while (__builtin_amdgcn_s_memrealtime() - t0 < (unsigned long long)ticks) __builtin_amdgcn_s_sleep(2); }
}
enum { PH_PRO = 0, PH_P1 = 1, PH_PREP = 2, PH_MIX = 3, PH_MIX2 = 4, PH_MERGE = 5, PH_WOUT = 6, PH_HN = 7, PH_PQ = 8, PH_TOPK = 9, PH_PEER1 = 10, PH_PEER2 = 11, PH_N = 12 };

__global__ void __launch_bounds__(NTHR, 2) mk_fwd(Args args) {
    extern __shared__ __attribute__((aligned(16))) uchar lds_raw[];
    LAS uchar* lds = (LAS uchar*)lds_raw;
    volatile LAS unsigned* MISC = (volatile LAS unsigned*)(lds + MISC_OFF);
    int tid = threadIdx.x, lane = tid & 63, wave = __builtin_amdgcn_readfirstlane(tid >> 6);
    const int wave_s = wave;
    const int G = gridDim.x, bx = blockIdx.x;
#define REFRESH_TID() do { tid = wave_s * 64 + fresh_lane(); lane = tid & 63; wave = wave_s; gw = bx * NWAVES + wave; } while (0)
    uchar* ws = args.ws;
    unsigned* ctl = (unsigned*)(ws + WS_CTL);
    for (int u = tid; u < (LDS_BYTES - LDSCTL_OFF) / 4; u += NTHR) ((LAS unsigned*)(lds + LDSCTL_OFF))[u] = 0u;
    __syncthreads();
    const int lo = args.ph_lo, hi = args.ph_hi;
    const bool multi = (hi - lo) > 1;
#ifndef TOPK_PROBE
#define TOPK_PROBE 0
#endif
#ifndef PRO_EXTRA
#define PRO_EXTRA 0
#endif
#ifndef PROBE_MASK
#define PROBE_MASK (TOPK_PROBE ? 0x40000000 : 0)
#endif
    unsigned long long pr_acc = 0ull, pr_t0 = PROBE_MASK ? __builtin_amdgcn_s_memrealtime() : 0ull;
#define PROBE_MARK(k) do { if (PROBE_MASK) { const unsigned long long t_ = __builtin_amdgcn_s_memrealtime(); if ((PROBE_MASK >> (k)) & 1) pr_acc += t_ - pr_t0; pr_t0 = t_; } } while (0)
    XcdBarrier bar; bar.bar = ctl + CW_BAR; bar.x = 0; bar.st = nullptr;
    if (multi) bar = xcd_barrier_post(ctl + CW_BAR, MISC + 8);
#define IN(k) (lo <= (k) && (k) < hi)
#define BOTH(k) (IN(k) && IN((k) + 1))
#define GRID_BAR() xcd_barrier(bar, wave_s * 64 + fresh_lane())
    int gw = bx * NWAVES + wave; const int NGW = G * NWAVES;

    if (IN(PH_PRO)) {
        REFRESH_TID();
        LAS float* scr = (LAS float*)(lds + wave * 16384);
        const float* w_in = args.in[3]; const float* w_kv = args.in[11]; const float* w_bg = args.in[14]; const float* w_bs = args.in[15]; const float* w_bm = args.in[16];
        const float* w_out = args.in[17]; const float* w_q = args.in[19];
        bf16* win_t = (bf16*)(ws + WS_WIN_T); bf16* wkv_t = (bf16*)(ws + WS_WKV_T); bf16* wbr_t = (bf16*)(ws + WS_WBR_T); bf16* wout_t = (bf16*)(ws + WS_WOUT_T); bf16* wq_t = (bf16*)(ws + WS_WQ_T);
        constexpr int KB = D / 64;
        constexpr int I_A = KB * (12288 / 32), I_B = KB * (21504 / 32), I_G = KB, I_KV = KB * (8192 / 32), I_BR = KB * (4096 / 32), I_Q = KB * (2048 / 32);
        constexpr int NIT = I_A + I_B + I_G + I_KV + 2 * I_BR; (void)I_Q;
        const bool fold_first = ((bx >> 3) & 1) != 0;
        for (int pass_ = 0; pass_ < 2; ++pass_) {
        if ((pass_ == 0) != fold_first) {
        for (int rep_ = 0; rep_ < 1 + (PRO_EXTRA & 1); ++rep_)
        for (int it = gw; it < NIT; it += NGW) {
            int r = it;
            if (r < I_A) { const int nb = r % 384, kb = r / 384, sc0 = nb * 32;
                const int dr = sc0 < 2048 ? sc0 : (sc0 < 4096 ? sc0 + 4096 : (sc0 < 8192 ? sc0 + 4096 : sc0 - 6144));
                if (dr < P1_NB16 * 256) transpose_item(w_in, DIN, D, win_t, kb * 64, sc0, dr, 32, scr, lane); else transpose_item8(w_in, DIN, D, ws + WS_WIN8, kb * 64, sc0, dr, 32, 512.f, scr, lane);
                continue; } r -= I_A;
            if (r < I_B) { const int nb = r % 672, kb = r / 672; transpose_item8(w_in, DIN, D, ws + WS_WIN8, kb * 64, 12304 + nb * 32, 12288 + nb * 32, 32, 512.f, scr, lane); continue; } r -= I_B;
            if (r < I_G) { transpose_item8(w_in, DIN, D, ws + WS_WIN8, r * 64, 12288, 33792, 16, 512.f, scr, lane); continue; } r -= I_G;
            if (r < I_KV) { const int nb = r % 256, kb = r / 256; transpose_item8(w_kv, 8192, D, (uchar*)wkv_t, kb * 64, nb * 32, nb * 32, 32, 512.f, scr, lane); continue; } r -= I_KV;
            if (r < 2 * I_BR) { const int w = r / I_BR, q = r % I_BR, nb = q % 128, kb = q / 128;
                const float* src = w == 0 ? w_bg : (w == 1 ? w_bs : (w == 2 ? w_bm : w_out)); uchar* dst = w < 3 ? (uchar*)wbr_t + (size_t)w * 4096 * 4096 : (uchar*)wout_t;
                transpose_item8(src, 4096, D, dst, kb * 64, nb * 32, nb * 32, 32, 512.f, scr, lane); }
        }
        } else {
        {
            __syncthreads();
            LAS float* wq_s = (LAS float*)lds;
            LAS float* kh_s = (LAS float*)(lds + 64 * 132 * 4);
            const float* subk = args.in[20];
            const int ng = tid & 31, kg = tid >> 5;
            for (int rep_ = 0; rep_ < 1 + ((PRO_EXTRA >> 1) & 1); ++rep_)
            for (int it = bx; it < 16 * 64; it += G) {
                const int hp = it >> 6, kb = it & 63;
#pragma unroll
                for (int r = 0; r < 4; ++r) { const int idx = tid + 512 * r, row = idx >> 5, c4 = idx & 31;
                    *(LAS f32x4*)(wq_s + row * 132 + c4 * 4) = *(const GAS f32x4*)(w_q + (size_t)(kb * 64 + row) * 2048 + hp * 128 + c4 * 4) * args.in[18][kb * 64 + row]; }
#pragma unroll
                for (int r = 0; r < 8; ++r) { const int idx = tid + 512 * r, row = idx >> 5, c4 = idx & 31;
                    *(LAS f32x4*)(kh_s + row * 132 + c4 * 4) = *(const GAS f32x4*)(subk + ((size_t)hp * 128 + row) * 128 + c4 * 4); }
                __syncthreads();
                f32x2 acc2[4][4];
#pragma unroll
                for (int i = 0; i < 4; ++i)
#pragma unroll
                    for (int j = 0; j < 4; ++j) acc2[i][j] = (f32x2){0.f, 0.f};
                for (int d4 = 0; d4 < 32; ++d4) {
                    f32x4 a[4], b[4];
#pragma unroll
                    for (int i = 0; i < 4; ++i) { a[i] = *(const LAS f32x4*)(wq_s + (4 * kg + i) * 132 + 4 * d4); b[i] = *(const LAS f32x4*)(kh_s + (4 * ng + i) * 132 + 4 * d4); }
#pragma unroll
                    for (int i = 0; i < 4; ++i)
#pragma unroll
                        for (int j = 0; j < 4; ++j) { acc2[i][j] = __builtin_elementwise_fma((f32x2){a[i].x, a[i].y}, (f32x2){b[j].x, b[j].y}, acc2[i][j]); acc2[i][j] = __builtin_elementwise_fma((f32x2){a[i].z, a[i].w}, (f32x2){b[j].z, b[j].w}, acc2[i][j]); }
                }
                float acc[4][4];
#pragma unroll
                for (int i = 0; i < 4; ++i)
#pragma unroll
                    for (int j = 0; j < 4; ++j) acc[i][j] = acc2[i][j].x + acc2[i][j].y;
#pragma unroll
                for (int j = 0; j < 4; ++j) { v2u w; w.x = pk2(acc[0][j], acc[1][j]); w.y = pk2(acc[2][j], acc[3][j]);
                    *(GAS v2u*)(wq_t + (size_t)(hp * 128 + 4 * ng + j) * D + kb * 64 + 4 * kg) = w; }
                __syncthreads();
            }
        }
        }
        }
        { v4u z = {0u, 0u, 0u, 0u}; GAS v4u* p = (GAS v4u*)(ws + WS_WIN8 + (size_t)33808 * D); const size_t n16 = (size_t)240 * D / 16;
          for (size_t i = (size_t)bx * NTHR + tid; i < n16; i += (size_t)G * NTHR) p[i] = z; }
        for (int rep_ = 0; rep_ < 1 + ((PRO_EXTRA >> 2) & 1); ++rep_)
        for (int m = gw; m < T; m += NGW) rms_row_to_bf16(args.in[0] + (size_t)m * D, args.in[2], P1_NB16 ? (bf16*)(ws + WS_XN) + (size_t)m * D : nullptr, lane, ws + WS_XN8 + (size_t)m * D);
        for (int m = gw; m < BATCH * MEM; m += NGW) rms_row_to_bf16(args.in[1] + (size_t)m * D, args.in[10], nullptr, lane, ws + WS_MEMN + (size_t)m * D);
        if (BOTH(PH_PRO)) GRID_BAR();
        PROBE_MARK(PH_PRO);
    }
    if (IN(PH_P1)) {
        stagger_wait((unsigned)((bx >> 3) & 3) * STAG_P1);
        if (P1_NB16 > 0) { pg8::GemmG g{D, D, D}; SchedP1 S{ws, G, bx, false}; pg8::EpiBf16 E; pg8::gemm_phase<pg8::EpiBf16, SchedP1>(lds, g, S, E, wave_s); }
        { pg8::GemmG g{D / 2, D / 2, D / 2}; SchedP1 S{ws, G, bx, true}; pg8::EpiBf16T<true> E; pg8::gemm_phase<pg8::EpiBf16T<true>, SchedP1>(lds, g, S, E, wave_s); }
        {
            REFRESH_TID();
            const int rem = 8576 % G, nlight = rem == 0 ? G : G - rem, lidx = rem == 0 ? bx : bx - rem;
            if (lidx >= 0) { LAS float* scr2 = (LAS float*)(lds + wave * 16384); constexpr int I_BR2 = (D / 64) * (4096 / 32);
                for (int it = lidx * NWAVES + wave; it < 2 * I_BR2; it += nlight * NWAVES) { const int w = it / I_BR2, q = it % I_BR2, nb = q % 128, kb = q / 128;
                    const float* src = w == 0 ? args.in[16] : args.in[17]; uchar* dst = w == 0 ? (uchar*)(ws + WS_WBR_T) + (size_t)2 * 4096 * 4096 : (uchar*)(ws + WS_WOUT_T);
                    transpose_item8(src, 4096, D, dst, kb * 64, nb * 32, nb * 32, 32, 512.f, scr2, lane); } }
        }
        if (BOTH(PH_P1)) GRID_BAR();
        PROBE_MARK(PH_P1);
    }
    if (IN(PH_PREP)) {
        REFRESH_TID();
        if (FAST_FLAGS & 1) {
            bf16* kvm = (bf16*)(ws + WS_KVM); const float* gq = args.in[12]; const float* gk = args.in[13];
            for (int it = gw; it < 512 * 4; it += NGW) { const int j = it >> 2, h = it & 3; bf16* p = kvm + (size_t)j * 8192 + h * 1024 + lane * 16;
                const v4u a = *(const GAS v4u*)p, b2 = *(const GAS v4u*)(p + 8);
                float v[16] = {bflo(a.x), bfhi(a.x), bflo(a.y), bfhi(a.y), bflo(a.z), bfhi(a.z), bflo(a.w), bfhi(a.w), bflo(b2.x), bfhi(b2.x), bflo(b2.y), bfhi(b2.y), bflo(b2.z), bfhi(b2.z), bflo(b2.w), bfhi(b2.w)};
                float ss = 0.f;
#pragma unroll
                for (int i = 0; i < 16; ++i) ss += v[i] * v[i];
                const float r = rsqrtf(wave_sum(ss) * (1.f / 1024.f) + EPS) * 0.03125f;
#pragma unroll
                for (int i = 0; i < 16; ++i) v[i] *= r * gk[lane * 16 + i] * gq[lane * 16 + i];
                v4u o0, o1; o0.x = pk2(v[0], v[1]); o0.y = pk2(v[2], v[3]); o0.z = pk2(v[4], v[5]); o0.w = pk2(v[6], v[7]); o1.x = pk2(v[8], v[9]); o1.y = pk2(v[10], v[11]); o1.z = pk2(v[12], v[13]); o1.w = pk2(v[14], v[15]);
                *(GAS v4u*)p = o0; *(GAS v4u*)(p + 8) = o1; }
            for (int it = gw; it < 4096; it += NGW) { const int b = it >> 11, r = it & 2047, cg = r >> 5, jg = r & 31, c = cg * 64 + lane; unsigned short x[8];
#pragma unroll
                for (int i = 0; i < 8; ++i) x[i] = kvm[(size_t)(b * 256 + jg * 8 + i) * 8192 + 4096 + c];
                v4u w; w.x = x[0] | ((unsigned)x[1] << 16); w.y = x[2] | ((unsigned)x[3] << 16); w.z = x[4] | ((unsigned)x[5] << 16); w.w = x[6] | ((unsigned)x[7] << 16);
                *(GAS v4u*)((bf16*)(ws + WS_VTM) + ((size_t)b * 4096 + c) * 256 + jg * 8) = w; }
            for (int it0 = gw; it0 < T * 4; it0 += 8 * NGW) {
                v4u ra[8], rb[8];
#pragma unroll
                for (int u = 0; u < 8; ++u) { const int it_ = it0 + u * NGW, it = it_ < T * 4 ? it_ : it0; const bf16* p = (const bf16*)(ws + WS_MQ) + (size_t)(it >> 2) * 4096 + (it & 3) * 1024 + lane * 16;
                    ra[u] = *(const GAS v4u*)p; rb[u] = *(const GAS v4u*)(p + 8); }
#pragma unroll
                for (int u = 0; u < 8; ++u) { const int it = it0 + u * NGW; const unsigned w8[8] = {ra[u].x, ra[u].y, ra[u].z, ra[u].w, rb[u].x, rb[u].y, rb[u].z, rb[u].w}; float ss = 0.f;
#pragma unroll
                    for (int i = 0; i < 8; ++i) { const float lo_ = bflo(w8[i]), hi_ = bfhi(w8[i]); ss += lo_ * lo_ + hi_ * hi_; }
                    ss = wave_sum(ss);
                    if (lane == 0 && it < T * 4) ((float*)(ws + WS_RQ))[it] = rsqrtf(ss * (1.f / 1024.f) + EPS); } }
        }
        if (FAST_FLAGS & 4) {
            __syncthreads();
            for (int it = bx; it < 2048; it += G) gla_prep_item(lds, ws, args.in[4], args.in[5], it, tid);
        }
        if (BOTH(PH_PREP)) GRID_BAR();
        PROBE_MARK(PH_PREP);
    }
    if (IN(PH_MIX)) {
        if (FAST_FLAGS & 4) {
            REFRESH_TID();
            for (int u0 = bx; u0 < 256; u0 += G) { const int u = (G == 256) ? ((u0 & 7) * 32 + (u0 >> 3)) : u0; gla_scan_unit(lds, ws, u, tid); }
        }
        PROBE_MARK(12);
        if (FAST_FLAGS & 1) {
            pg8::GemmG g{4096, 8192, 1024}; SchedMemS S{ws, G, bx}; pg8::EpiMemS E{(const float*)(ws + WS_RQ), (bf16*)(ws + WS_PM), (LAS float*)(lds + LDSCTL_OFF + 2048)};
            pg8::gemm_phase<pg8::EpiMemS, SchedMemS>(lds, g, S, E, wave_s);
        }
        PROBE_MARK(13);
        if (FAST_FLAGS & 2) {
            REFRESH_TID();
            for (int u = bx; u < 1024; u += G) { const int b = u >> 9, blk = (u >> 3) & 63, kvh = u & 7;
                swa_unit(lds, (const bf16*)(ws + WS_SQ), (const bf16*)(ws + WS_SK), (const bf16*)(ws + WS_SV), ws + WS_OB8, args.in[7], args.in[8], args.in[9], b, blk, kvh, tid); }
        }
        if (BOTH(PH_MIX)) GRID_BAR();
        PROBE_MARK(PH_MIX);
    }
    if (IN(PH_MIX2)) {
        if (FAST_FLAGS & 1) {
            pg8::GemmG g{1024, 256, 256}; SchedMemO S{ws, G, bx}; pg8::EpiOutFp8 E;
            pg8::gemm_phase<pg8::EpiOutFp8, SchedMemO>(lds, g, S, E, wave_s);
        }
        if (FAST_FLAGS & 4) {
            REFRESH_TID();
            for (int it = gw; it < T * 8; it += 4 * NGW) gla_post_items<4>(ws, args.in[6], it, NGW, lane);
        }
        if (BOTH(PH_MIX2)) GRID_BAR();
        PROBE_MARK(PH_MIX2);
    }
    if (IN(PH_MERGE)) {
        stagger_wait((unsigned)((bx >> 3) & 3) * STAG_MERGE);
        pg8::GemmG g{D / 2, D / 2, D / 2}; SchedMerge S{ws, G, bx}; pg8::EpiMerge E{(const bf16*)(ws + WS_GATE), ws + WS_MIX8};
        pg8::gemm_phase<pg8::EpiMerge, SchedMerge>(lds, g, S, E, wave_s);
        if (BOTH(PH_MERGE)) GRID_BAR();
        PROBE_MARK(PH_MERGE);
    }
    if (IN(PH_WOUT)) {
        stagger_wait((unsigned)((bx >> 3) & 3) * STAG_WOUT);
        pg8::GemmG g{D / 2, D / 2, D / 2}; SchedPlain S{(const char*)(ws + WS_MIX8), (const char*)(ws + WS_WOUT_T), nullptr, 64, 16, D / 2, 4, G, bx, 0.00006103515625f}; EpiWoutHB E{args.in[0], (bf16*)(ws + WS_HB)};
        pg8::gemm_phase<EpiWoutHB, SchedPlain>(lds, g, S, E, wave_s);
        if (BOTH(PH_WOUT)) GRID_BAR();
        PROBE_MARK(PH_WOUT);
    }
    if (IN(PH_HN)) {
        PROBE_MARK(PH_HN);
    }
    if (IN(PH_PQ)) {
        {
            REFRESH_TID();
            for (int m0 = gw; m0 < T; m0 += 4 * NGW) { v4u hx[4][8];
#pragma unroll
                for (int u = 0; u < 4; ++u) { const int m_ = m0 + u * NGW, m = m_ < T ? m_ : m0; const GAS v4u* hrow = (const GAS v4u*)((const bf16*)(ws + WS_HB) + (size_t)m * D) + lane;
#pragma unroll
                    for (int q = 0; q < 8; ++q) hx[u][q] = hrow[64 * q]; }
#pragma unroll
                for (int u = 0; u < 4; ++u) { const int m_ = m0 + u * NGW, m = m_ < T ? m_ : m0; float hss = 0.f;
#pragma unroll
                    for (int q = 0; q < 8; ++q) { const v4u a = hx[u][q]; const float e8[8] = {bflo(a.x), bfhi(a.x), bflo(a.y), bfhi(a.y), bflo(a.z), bfhi(a.z), bflo(a.w), bfhi(a.w)};
#pragma unroll
                        for (int i = 0; i < 8; ++i) hss += e8[i] * e8[i]; }
                    const float rs = rsqrtf(wave_sum(hss) * (1.f / 4096.f) + EPS), r8 = 8.f * rs;
                    if (lane == 0) ((float*)(ws + WS_RQ))[m] = rs;
#pragma unroll
                    for (int q = 0; q < 8; ++q) { const v4u a = hx[u][q]; v2u w8; w8.x = pg8::pk4_fp8(r8 * bflo(a.x), r8 * bfhi(a.x), r8 * bflo(a.y), r8 * bfhi(a.y)); w8.y = pg8::pk4_fp8(r8 * bflo(a.z), r8 * bfhi(a.z), r8 * bflo(a.w), r8 * bfhi(a.w));
                        ((GAS v2u*)(ws + WS_HN8 + (size_t)m * D))[lane + 64 * q] = w8; } } }
        }
        pg8::GemmG g{D, D, D}; SchedPlain S{(const char*)(ws + WS_HB), (const char*)(ws + WS_WQ_T), (char*)(ws + WS_QP), 64, 8, D, 4, G, bx, 1.f}; pg8::EpiF32 E{nullptr};
        pg8::gemm_phase<pg8::EpiF32, SchedPlain>(lds, g, S, E, wave_s);
        if (BOTH(PH_PQ)) GRID_BAR();
        PROBE_MARK(PH_PQ);
    }
    if (IN(PH_TOPK)) {
        REFRESH_TID();
        LAS float* grow0 = (LAS float*)lds;
        LAS float* topv = (LAS float*)(lds + LDSCTL_OFF + 2048) + wave * 32;
        LAS int* topi = (LAS int*)(lds + LDSCTL_OFF + 2048 + 1024) + wave * 32;
        for (int i = tid; i < 32768; i += NTHR) grow0[i] = 0.f;
        __syncthreads();
        const float* sc = (const float*)(ws + WS_QP); bf16* ga = (bf16*)(ws + WS_GA);
        const unsigned long long ltmask = (1ull << lane) - 1ull;
        const float* usrc = args.in[21]; const float* vsrc = args.in[22]; const int gw8 = bx * 8 + wave; int jj = 0;
        int par = 0; float nv_[2][2];
        { const float* sp0 = sc + (size_t)bx * 2048 + wave * 256;
#pragma unroll
          for (int p = 0; p < 2; ++p) { nv_[p][0] = sp0[p * 128 + lane]; nv_[p][1] = sp0[p * 128 + 64 + lane]; } }
        asm volatile("" : "+v"(nv_[0][0]), "+v"(nv_[0][1]), "+v"(nv_[1][0]), "+v"(nv_[1][1]));
        for (int t = bx; t < T; t += G, par ^= 1, ++jj) {
            LAS float* grow = grow0 + par * 16384;
            const unsigned long long tk0_ = TOPK_PROBE ? __builtin_amdgcn_s_memrealtime() : 0ull;
            float v[2][2];
#pragma unroll
            for (int p = 0; p < 2; ++p) { v[p][0] = nv_[p][0]; v[p][1] = nv_[p][1]; }
            { const int tn = (t + G < T) ? t + G : t; const float* spn = sc + (size_t)tn * 2048 + wave * 256;
#pragma unroll
              for (int p = 0; p < 2; ++p) { nv_[p][0] = spn[p * 128 + lane]; nv_[p][1] = spn[p * 128 + 64 + lane]; } }
            const int cit0 = (jj >> 1) * (8 * G) + gw8, cit = cit0 < 65535 ? cit0 : 65535, chalf = jj & 1;
            const float rstd = ((const GAS float*)(ws + WS_RQ))[t + (fresh_lane() >> 6)];
            const GAS f32x4* up = (const GAS f32x4*)(usrc + (size_t)cit * 1024 + chalf * 512) + lane * 2;
            const GAS f32x4* ugp = (const GAS f32x4*)(args.in[18] + ((cit * 1024 + chalf * 512) & 4095)) + lane * 2; const f32x4 ug0 = ugp[0], ug1 = ugp[1];
            const int cvt0 = (jj >> 3) * (8 * G) + gw8, cvt = cvt0 < 16383 ? cvt0 : 16383, cv8 = jj & 7;
            const GAS float* vp = (const GAS float*)(vsrc + ((size_t)(cvt >> 6) * 64 + cv8 * 8) * 4096 + (cvt & 63) * 64);
            const f32x4 cu0 = up[0], cu1 = up[1]; float cv_[8];
#pragma unroll
            for (int q = 0; q < 8; ++q) cv_[q] = vp[q * 4096 + lane];
            bool slp[2][2]; select16_pair(v[0], v[1], slp[0], slp[1], lane);
#pragma unroll
            for (int p = 0; p < 2; ++p) {
                const bool sl[2] = {slp[p][0], slp[p][1]};
                const unsigned long long m0 = __ballot(sl[0]), m1 = __ballot(sl[1]);
                if (sl[0]) { const int slot = __popcll(m0 & ltmask); topv[p * 16 + slot] = v[p][0]; topi[p * 16 + slot] = lane; }
                if (sl[1]) { const int slot = __popcll(m0) + __popcll(m1 & ltmask); topv[p * 16 + slot] = v[p][1]; topi[p * 16 + slot] = 64 + lane; }
            }
            LDS_WAIT();
            float cv[4];
#pragma unroll
            for (int r = 0; r < 4; ++r) { const int c = lane + 64 * r; cv[r] = topv[c >> 4] + topv[16 + (c & 15)]; }
            bool sel[4]; select16<4>(cv, sel, lane);
            float mx = fmaxf(fmaxf(cv[0], cv[1]), fmaxf(cv[2], cv[3]));
            mx = wave_max(mx);
            float e[4], es = 0.f;
#pragma unroll
            for (int r = 0; r < 4; ++r) { e[r] = sel[r] ? __expf((cv[r] - mx) * rstd) : 0.f; es += e[r]; }
            es = wave_sum(es);
            const float inv = 1.0f / es;
#pragma unroll
            for (int r = 0; r < 4; ++r) if (sel[r]) { const int c = lane + 64 * r; const int ex = topi[c >> 4] * 128 + topi[16 + (c & 15)]; (void)__hip_atomic_fetch_add(grow + ex, e[r] * inv, __ATOMIC_RELAXED, __HIP_MEMORY_SCOPE_WORKGROUP); }
            if (TOPK_PROBE == 1) pr_acc += __builtin_amdgcn_s_memrealtime() - tk0_;
            {   v2u wu, wv; wu.x = pg8::pk4_fp8(512.f * cu0.x * ug0.x, 512.f * cu0.y * ug0.y, 512.f * cu0.z * ug0.z, 512.f * cu0.w * ug0.w); wu.y = pg8::pk4_fp8(512.f * cu1.x * ug1.x, 512.f * cu1.y * ug1.y, 512.f * cu1.z * ug1.z, 512.f * cu1.w * ug1.w);
                wv.x = pg8::pk4_fp8(16.f * cv_[0], 16.f * cv_[1], 16.f * cv_[2], 16.f * cv_[3]); wv.y = pg8::pk4_fp8(16.f * cv_[4], 16.f * cv_[5], 16.f * cv_[6], 16.f * cv_[7]);
                ((GAS v2u*)(ws + WS_U8 + (size_t)cit * 1024 + chalf * 512))[lane] = wu;
                ((GAS v2u*)(ws + WS_V8T + (size_t)(cvt >> 6) * (4096 * 64) + (size_t)((cvt & 63) * 64) * 64 + cv8 * 8))[lane * 8] = wv; }
            asm volatile("" : "+v"(nv_[0][0]), "+v"(nv_[0][1]), "+v"(nv_[1][0]), "+v"(nv_[1][1]));
            LDS_WAIT(); __builtin_amdgcn_s_barrier(); asm volatile("" ::: "memory");
            {
                LAS f32x4* rp = (LAS f32x4*)grow + tid; GAS unsigned* gp = (GAS unsigned*)((uchar*)ga + (size_t)t * 16384) + tid;
#pragma unroll
                for (int q = 0; q < 8; ++q) { const f32x4 a = rp[512 * q] * 64.f; gp[512 * q] = pg8::pk4_fp8(a.x, a.y, a.z, a.w); rp[512 * q] = (f32x4){0.f, 0.f, 0.f, 0.f}; }
            }
            if (TOPK_PROBE == 2) pr_acc += __builtin_amdgcn_s_memrealtime() - tk0_;
        }
        for (int j2 = jj >> 1; j2 * (8 * G) + gw8 < 65536; ++j2) { const int cit = j2 * (8 * G) + gw8; const GAS f32x4* up = (const GAS f32x4*)usrc + ((size_t)cit * 64 + lane) * 4; v4u w;
            const GAS f32x4* tg = (const GAS f32x4*)(args.in[18] + ((cit * 1024) & 4095)) + lane * 4;
            { const f32x4 a = up[0] * tg[0] * 512.f; w.x = pg8::pk4_fp8(a.x, a.y, a.z, a.w); } { const f32x4 a = up[1] * tg[1] * 512.f; w.y = pg8::pk4_fp8(a.x, a.y, a.z, a.w); }
            { const f32x4 a = up[2] * tg[2] * 512.f; w.z = pg8::pk4_fp8(a.x, a.y, a.z, a.w); } { const f32x4 a = up[3] * tg[3] * 512.f; w.w = pg8::pk4_fp8(a.x, a.y, a.z, a.w); }
            ((GAS v4u*)(ws + WS_U8))[(size_t)cit * 64 + lane] = w; }
        for (int j3 = jj >> 3; j3 * (8 * G) + gw8 < 16384; ++j3) { const int cvt = j3 * (8 * G) + gw8;
            for (int c8 = 0; c8 < 8; ++c8) { const GAS float* vp = (const GAS float*)(vsrc + ((size_t)(cvt >> 6) * 64 + c8 * 8) * 4096 + (cvt & 63) * 64); float c_[8];
#pragma unroll
                for (int q = 0; q < 8; ++q) c_[q] = 16.f * vp[q * 4096 + lane];
                v2u w; w.x = pg8::pk4_fp8(c_[0], c_[1], c_[2], c_[3]); w.y = pg8::pk4_fp8(c_[4], c_[5], c_[6], c_[7]);
                ((GAS v2u*)(ws + WS_V8T + (size_t)(cvt >> 6) * (4096 * 64) + (size_t)((cvt & 63) * 64) * 64 + c8 * 8))[lane * 8] = w; } }
        LDS_WAIT(); __syncthreads();
        if (BOTH(PH_TOPK)) GRID_BAR();
        PROBE_MARK(PH_TOPK);
    }
    if (IN(PH_PEER1)) {
        stagger_wait((unsigned)((bx >> 3) & 3) * STAG_PEER1);
        pg8::GemmG g{2048, 2048, 2048};
        SchedPlain S{(const char*)(ws + WS_HN8), (const char*)(ws + WS_U8), (char*)(ws + WS_A8), 64, 64, 2048, 1, G, bx, 1.f}; pg8::EpiPeerA8 E{(const uchar*)(ws + WS_GA), ws + WS_A8};
        pg8::gemm_phase<pg8::EpiPeerA8, SchedPlain>(lds, g, S, E, wave_s);
        if (BOTH(PH_PEER1)) GRID_BAR();
        PROBE_MARK(PH_PEER1);
    }
    if (IN(PH_PEER2)) {
        stagger_wait((unsigned)((bx >> 3) & 3) * STAG_PEER2);
        pg8::GemmG g{8192, 4096 * 64, 8192}; SchedPeer2 S{(const char*)(ws + WS_A8), (const char*)(ws + WS_V8T), nullptr, G, bx, 0.0009765625f}; EpiPeer2 E{(const bf16*)(ws + WS_HB), args.out};
        pg8::gemm_phase<EpiPeer2, SchedPeer2>(lds, g, S, E, wave_s);
        PROBE_MARK(PH_PEER2);
    }
    if (PROBE_MASK) { const unsigned long long t0_ = __builtin_amdgcn_s_memrealtime(); while (__builtin_amdgcn_s_memrealtime() - t0_ < pr_acc) __builtin_amdgcn_s_sleep(8); }
#undef IN
#undef BOTH
#undef GRID_BAR
}

namespace nv {
__device__ __forceinline__ float ldb(const bf16* p) { return bf2f(*p); }
__device__ __forceinline__ float block_sum(float v, float* red) {
    v = wave_sum(v); __syncthreads();
    if ((threadIdx.x & 63) == 0) red[threadIdx.x >> 6] = v;
    __syncthreads();
    float s = 0.f; for (int i = 0; i < (int)(blockDim.x >> 6); ++i) s += red[i];
    return s;
}
__device__ __forceinline__ float block_max(float v, float* red) {
    v = wave_max(v); __syncthreads();
    if ((threadIdx.x & 63) == 0) red[threadIdx.x >> 6] = v;
    __syncthreads();
    float s = red[0]; for (int i = 1; i < (int)(blockDim.x >> 6); ++i) s = fmaxf(s, red[i]);
    return s;
}
__global__ void k_headnorm(bf16* x, long ldx, int nheads, int hd, const float* gain, long nrows) {
    const long w = ((long)blockIdx.x * blockDim.x + threadIdx.x) >> 6; const int lane = threadIdx.x & 63;
    if (w >= nrows * nheads) return;
    const long r = w / nheads; const int h = (int)(w % nheads);
    bf16* p = x + r * ldx + (long)h * hd;
    float s = 0.f;
    for (int i = lane; i < hd; i += 64) { float v = ldb(p + i); s += v * v; }
    s = wave_sum(s);
    const float rr = rsqrtf(s / (float)hd + EPS);
    for (int i = lane; i < hd; i += 64) p[i] = (bf16)f2bf(ldb(p + i) * rr * gain[i]);
}
__global__ void k_gla_decay(const bf16* glrp, const float* wup, const float* bias, float* dec) {
    const long i = (long)blockIdx.x * blockDim.x + threadIdx.x;
    if (i >= (long)T * 2048) return;
    const long t = i / 2048; const int c = (int)(i % 2048);
    const bf16* g = glrp + t * 256;
    float s = bias[c];
    for (int r = 0; r < 16; ++r) s = fmaf(ldb(g + r), wup[r * 2048 + c], s);
    const float ls = fminf(s, 0.f) - log1pf(expf(-fabsf(s)));
    dec[i] = expf(ls * (1.0f / 16.0f));
}
__global__ __launch_bounds__(256) void k_gla_scan(const bf16* gq, const bf16* gk, bf16* gv, const float* dec) {
    const int h = blockIdx.y, e = blockIdx.x * 64 + (threadIdx.x >> 2), qd = threadIdx.x & 3; const long t0 = (long)blockIdx.z * SEQ;
    float S[64];
#pragma unroll
    for (int i = 0; i < 64; ++i) S[i] = 0.f;
    for (long t = t0; t < t0 + SEQ; ++t) {
        const bf16* pq = gq + t * 2048 + h * 256 + qd * 64; const bf16* pk = gk + t * 2048 + h * 256 + qd * 64; const float* pa = dec + t * 2048 + h * 256 + qd * 64;
        const float v = ldb(gv + t * 4096 + h * 512 + e);
        float o = 0.f;
#pragma unroll
        for (int i = 0; i < 64; i += 4) {
            const v2u qw = *(const v2u*)(pq + i), kw = *(const v2u*)(pk + i); const float4 a4 = *(const float4*)(pa + i);
            S[i + 0] = fmaf(a4.x, S[i + 0], bflo(kw.x) * v); o = fmaf(bflo(qw.x), S[i + 0], o);
            S[i + 1] = fmaf(a4.y, S[i + 1], bfhi(kw.x) * v); o = fmaf(bfhi(qw.x), S[i + 1], o);
            S[i + 2] = fmaf(a4.z, S[i + 2], bflo(kw.y) * v); o = fmaf(bflo(qw.y), S[i + 2], o);
            S[i + 3] = fmaf(a4.w, S[i + 3], bfhi(kw.y) * v); o = fmaf(bfhi(qw.y), S[i + 3], o);
        }
        o += __shfl_xor(o, 1); o += __shfl_xor(o, 2);
        if (qd == 0) gv[t * 4096 + h * 512 + e] = (bf16)f2bf(o);
    }
}
__global__ void k_gla_post(bf16* oa, const bf16* gr, const float* gain) {
    const long w = ((long)blockIdx.x * blockDim.x + threadIdx.x) >> 6; const int lane = threadIdx.x & 63;
    if (w >= (long)T * 8) return;
    const long t = w >> 3; const int h = (int)(w & 7);
    bf16* p = oa + t * 4096 + h * 512; const bf16* g = gr + t * 4096 + h * 512;
    float s = 0.f;
    for (int i = lane; i < 512; i += 64) { float v = ldb(p + i); s += v * v; }
    s = wave_sum(s);
    const float rr = rsqrtf(s / 512.f + EPS);
    for (int i = lane; i < 512; i += 64) { const float gg = ldb(g + i); p[i] = (bf16)f2bf(ldb(p + i) * rr * gain[h * 512 + i] * (gg / (1.f + expf(-gg)))); }
}
__global__ __launch_bounds__(256) void k_swa(bf16* sq, const bf16* sk, const bf16* sv, const float* sinks) {
    __shared__ float qs[4][64];
    __shared__ float ps[4][128];
    const int wl = threadIdx.x >> 6, lane = threadIdx.x & 63;
    const long w = (long)blockIdx.x * 4 + wl;
    const long t = w >> 6; const int hq = (int)(w & 63), kvh = hq >> 3; const long tb = (t / SEQ) * SEQ;
    qs[wl][lane] = ldb(sq + t * 4096 + hq * 64 + lane);
    __syncthreads();
    const float sink = sinks[hq];
    float sc[2];
#pragma unroll
    for (int r = 0; r < 2; ++r) {
        const long key = t - 127 + lane + r * 64;
        float s = -INFINITY;
        if (key >= tb) {
            const bf16* kp = sk + key * 512 + kvh * 64;
            float a = 0.f;
            for (int d = 0; d < 64; ++d) a = fmaf(qs[wl][d], ldb(kp + d), a);
            s = a * 0.125f;
        }
        sc[r] = s;
    }
    const float m = fmaxf(wave_max(fmaxf(sc[0], sc[1])), sink);
    const float p0 = expf(sc[0] - m), p1 = expf(sc[1] - m);
    const float den = wave_sum(p0 + p1) + expf(sink - m);
    ps[wl][lane] = p0 / den; ps[wl][lane + 64] = p1 / den;
    __syncthreads();
    float o = 0.f;
    for (int j = 0; j < 128; ++j) { const long key = t - 127 + j; if (key >= tb) o = fmaf(ps[wl][j], ldb(sv + key * 512 + kvh * 64 + lane), o); }
    sq[t * 4096 + hq * 64 + lane] = (bf16)f2bf(o);
}
__global__ __launch_bounds__(256) void k_memattn(bf16* mq, const bf16* kvm) {
    __shared__ float qs[8][1024];
    __shared__ float ps[8][256];
    __shared__ float red[8];
    const int hd = blockIdx.y; const long t0 = (long)blockIdx.x * 8; const int tid = threadIdx.x; const long b = t0 / SEQ;
    const bf16* kv = kvm + b * 256 * 8192;
    for (int i = tid; i < 8 * 1024; i += 256) qs[i >> 10][i & 1023] = ldb(mq + (t0 + (i >> 10)) * 4096 + hd * 1024 + (i & 1023));
    __syncthreads();
    float s[8];
#pragma unroll
    for (int r = 0; r < 8; ++r) s[r] = 0.f;
    const bf16* kp = kv + (long)tid * 8192 + hd * 1024;
    for (int d = 0; d < 1024; ++d) { const float kk = ldb(kp + d);
#pragma unroll
        for (int r = 0; r < 8; ++r) s[r] = fmaf(qs[r][d], kk, s[r]); }
    for (int r = 0; r < 8; ++r) {
        const float v = s[r] * 0.03125f;
        const float m = block_max(v, red);
        const float p = expf(v - m);
        const float den = block_sum(p, red);
        ps[r][tid] = p / den;
    }
    __syncthreads();
    float o[8][4];
#pragma unroll
    for (int r = 0; r < 8; ++r)
#pragma unroll
        for (int c = 0; c < 4; ++c) o[r][c] = 0.f;
    for (int j = 0; j < 256; ++j) {
        const bf16* vp = kv + (long)j * 8192 + 4096 + hd * 1024;
        float vv[4];
#pragma unroll
        for (int c = 0; c < 4; ++c) vv[c] = ldb(vp + tid + c * 256);
#pragma unroll
        for (int r = 0; r < 8; ++r) { const float p = ps[r][j];
#pragma unroll
            for (int c = 0; c < 4; ++c) o[r][c] = fmaf(p, vv[c], o[r][c]); }
    }
#pragma unroll
    for (int r = 0; r < 8; ++r)
#pragma unroll
        for (int c = 0; c < 4; ++c) mq[(t0 + r) * 4096 + hd * 1024 + tid + c * 256] = (bf16)f2bf(o[r][c]);
}
__global__ __launch_bounds__(256) void k_peer(float* io, const bf16* hn, const float* qp, const float* subk, const float* ut, const float* vt) {
    __shared__ float xs[4096];
    __shared__ float sc[2][128];
    __shared__ float tops[2][16];
    __shared__ int topi[2][16];
    __shared__ float cand[256];
    __shared__ float bests[16];
    __shared__ int beste[16];
    __shared__ float gate_s[128];
    __shared__ int exp_s[128];
    __shared__ float coef[128];
    const long t = blockIdx.x; const int tid = threadIdx.x, lane = tid & 63, wv = tid >> 6;
    for (int i = tid; i < 4096; i += 256) xs[i] = ldb(hn + t * 4096 + i);
    __syncthreads();
    for (int h = 0; h < 8; ++h) {
        { const int p = tid >> 7, n = tid & 127; const float* q = qp + t * 2048 + h * 256 + p * 128; const float* kk = subk + (((long)h * 2 + p) * 128 + n) * 128;
          float s = 0.f; for (int d = 0; d < 128; ++d) s = fmaf(q[d], kk[d], s); sc[p][n] = s; }
        __syncthreads();
        { const int p = tid >> 7, n = tid & 127; const float s = sc[p][n]; int rank = 0;
          for (int j = 0; j < 128; ++j) { const float o = sc[p][j]; rank += (o > s || (o == s && j < n)) ? 1 : 0; }
          if (rank < 16) { tops[p][rank] = s; topi[p][rank] = n; } }
        __syncthreads();
        cand[tid] = tops[0][tid >> 4] + tops[1][tid & 15];
        __syncthreads();
        { const float s = cand[tid]; int rank = 0;
          for (int j = 0; j < 256; ++j) { const float o = cand[j]; rank += (o > s || (o == s && j < tid)) ? 1 : 0; }
          if (rank < 16) { bests[rank] = s; beste[rank] = topi[0][tid >> 4] * 128 + topi[1][tid & 15]; } }
        __syncthreads();
        if (tid < 16) { const float m = bests[0]; float den = 0.f; for (int j = 0; j < 16; ++j) den += expf(bests[j] - m);
            gate_s[h * 16 + tid] = expf(bests[tid] - m) / den; exp_s[h * 16 + tid] = beste[tid]; }
        __syncthreads();
    }
    for (int j = wv * 32; j < wv * 32 + 32; ++j) {
        const float* up = ut + (long)exp_s[j] * 4096;
        float s = 0.f;
        for (int i = lane * 4; i < 4096; i += 256) { const float4 u4 = *(const float4*)(up + i); s = fmaf(u4.x, xs[i], s); s = fmaf(u4.y, xs[i + 1], s); s = fmaf(u4.z, xs[i + 2], s); s = fmaf(u4.w, xs[i + 3], s); }
        s = wave_sum(s);
        if (lane == 0) coef[j] = gate_s[j] * 0.5f * s * (1.0f + erff(s * 0.70710678118654752f));
    }
    __syncthreads();
    float y[16];
#pragma unroll
    for (int c = 0; c < 16; ++c) y[c] = 0.f;
    for (int j = 0; j < 128; ++j) {
        const float* vp = vt + (long)exp_s[j] * 4096; const float cf = coef[j];
#pragma unroll
        for (int c = 0; c < 4; ++c) { const float4 v4 = *(const float4*)(vp + c * 1024 + tid * 4); y[c * 4] = fmaf(cf, v4.x, y[c * 4]); y[c * 4 + 1] = fmaf(cf, v4.y, y[c * 4 + 1]); y[c * 4 + 2] = fmaf(cf, v4.z, y[c * 4 + 2]); y[c * 4 + 3] = fmaf(cf, v4.w, y[c * 4 + 3]); }
    }
#pragma unroll
    for (int c = 0; c < 4; ++c) { float4 o = *(float4*)(io + t * 4096 + c * 1024 + tid * 4); o.x += y[c * 4]; o.y += y[c * 4 + 1]; o.z += y[c * 4 + 2]; o.w += y[c * 4 + 3]; *(float4*)(io + t * 4096 + c * 1024 + tid * 4) = o; }
}
}

#ifndef DIFFTEST
#define DIFFTEST 0
#endif
namespace dbg {
__global__ void k_diff(const bf16* a, const bf16* b, size_t n, float* acc) {
    float d2 = 0.f, r2 = 0.f;
    for (size_t i = (size_t)blockIdx.x * blockDim.x + threadIdx.x; i < n; i += (size_t)gridDim.x * blockDim.x) { const float x = bf2f(a[i]), y = bf2f(b[i]); d2 += (x - y) * (x - y); r2 += y * y; }
    d2 = wave_sum(d2); r2 = wave_sum(r2);
    if ((threadIdx.x & 63) == 0) { atomicAdd(acc, d2); atomicAdd(acc + 1, r2); }
}
__global__ void k_scale(float* out, size_t n, const float* acc, float amp) {
    const float f = 1.0f + amp * sqrtf(acc[0] / fmaxf(acc[1], 1e-30f));
    for (size_t i = (size_t)blockIdx.x * blockDim.x + threadIdx.x; i < n; i += (size_t)gridDim.x * blockDim.x) out[i] *= f;
}
}
constexpr size_t WS_DBG_A = WS_END, WS_DBG_B = WS_END + 128 * MiB;

extern "C" void kernel_launch(void* const* d_in, const int* in_sizes, int n_in, void* d_out, int out_size, void* d_ws, size_t ws_size, hipStream_t stream) {
    static int grid = 0;
    if (grid == 0) {
        int dev = 0, cus = 0, per_cu = 0;
        if (hipGetDevice(&dev) != hipSuccess || hipDeviceGetAttribute(&cus, hipDeviceAttributeMultiprocessorCount, dev) != hipSuccess) { grid = -1; return; }
        if (hipFuncSetAttribute((const void*)mk_fwd, hipFuncAttributeMaxDynamicSharedMemorySize, LDS_BYTES) != hipSuccess) { grid = -1; return; }
        if (hipOccupancyMaxActiveBlocksPerMultiprocessor(&per_cu, (const void*)mk_fwd, NTHR, LDS_BYTES) != hipSuccess || per_cu < 1) fprintf(stderr, "occupancy query: %d\n", per_cu);
        (void)hipGetLastError();
        grid = cus;
        if (n_in != 23 || ws_size < WS_END) { fprintf(stderr, "kernel_launch: unexpected n_in %d / ws %zu\n", n_in, ws_size); }
    }
    if (grid < 0) return;
    (void)hipMemsetAsync((char*)d_ws + WS_CTL, 0, CTL_ZERO_BYTES, stream);
    Args a{};
    for (int i = 0; i < 23; ++i) a.in[i] = (const float*)d_in[i];
    a.out = (float*)d_out; a.ws = (uchar*)d_ws;
    uchar* ws = (uchar*)d_ws;
    a.flags = FAST_FLAGS;
    auto launch = [&](int lo, int hi) { a.ph_lo = lo; a.ph_hi = hi; hipLaunchKernelGGL(mk_fwd, dim3(grid), dim3(NTHR), LDS_BYTES, stream, a); };
#if FAST_FLAGS == 7 && DIFFTEST == 0 && !defined(MK_PER_PHASE)
    launch(PH_PRO, PH_N);
#else
    launch(PH_PRO, PH_PRO + 1);
    launch(PH_P1, PH_P1 + 1);
    {
        using namespace nv;
        float* dec = (float*)(ws + WS_XN);
#if DIFFTEST == 3
        (void)hipMemcpyAsync(ws + WS_DBG_A, ws + WS_GV, (size_t)128 * MiB, hipMemcpyDeviceToDevice, stream);
        k_gla_decay<<<(int)(((long)T * 2048 + 255) / 256), 256, 0, stream>>>((const bf16*)(ws + WS_GLRP), a.in[4], a.in[5], dec);
        k_gla_scan<<<dim3(8, 8, 2), 256, 0, stream>>>((const bf16*)(ws + WS_GQ), (const bf16*)(ws + WS_GK), (bf16*)(ws + WS_DBG_A), dec);
        k_gla_post<<<T * 8 / 4, 256, 0, stream>>>((bf16*)(ws + WS_DBG_A), (const bf16*)(ws + WS_GR), a.in[6]);
#endif
        if (!(FAST_FLAGS & 4)) {
        k_gla_decay<<<(int)(((long)T * 2048 + 255) / 256), 256, 0, stream>>>((const bf16*)(ws + WS_GLRP), a.in[4], a.in[5], dec);
        k_gla_scan<<<dim3(8, 8, 2), 256, 0, stream>>>((const bf16*)(ws + WS_GQ), (const bf16*)(ws + WS_GK), (bf16*)(ws + WS_GV), dec);
        k_gla_post<<<T * 8 / 4, 256, 0, stream>>>((bf16*)(ws + WS_GV), (const bf16*)(ws + WS_GR), a.in[6]);
        }
#if DIFFTEST == 2
        (void)hipMemcpyAsync(ws + WS_DBG_A, ws + WS_SQ, (size_t)128 * MiB, hipMemcpyDeviceToDevice, stream);
        (void)hipMemcpyAsync(ws + WS_DBG_B, ws + WS_SK, (size_t)16 * MiB, hipMemcpyDeviceToDevice, stream);
        k_headnorm<<<T * 64 / 4, 256, 0, stream>>>((bf16*)(ws + WS_DBG_A), 4096, 64, 64, a.in[7], T);
        k_headnorm<<<T * 8 / 4, 256, 0, stream>>>((bf16*)(ws + WS_DBG_B), 512, 8, 64, a.in[8], T);
        k_swa<<<T * 64 / 4, 256, 0, stream>>>((bf16*)(ws + WS_DBG_A), (const bf16*)(ws + WS_DBG_B), (const bf16*)(ws + WS_SV), a.in[9]);
#endif
        if (!(FAST_FLAGS & 2)) {
        k_headnorm<<<T * 64 / 4, 256, 0, stream>>>((bf16*)(ws + WS_SQ), 4096, 64, 64, a.in[7], T);
        k_headnorm<<<T * 8 / 4, 256, 0, stream>>>((bf16*)(ws + WS_SK), 512, 8, 64, a.in[8], T);
        k_swa<<<T * 64 / 4, 256, 0, stream>>>((bf16*)(ws + WS_SQ), (const bf16*)(ws + WS_SK), (const bf16*)(ws + WS_SV), a.in[9]);
        }
#if DIFFTEST == 1
        (void)hipMemcpyAsync(ws + WS_DBG_A, ws + WS_MQ, (size_t)128 * MiB, hipMemcpyDeviceToDevice, stream);
        (void)hipMemcpyAsync(ws + WS_DBG_B, ws + WS_KVM, (size_t)8 * MiB, hipMemcpyDeviceToDevice, stream);
        k_headnorm<<<512 * 4 / 4, 256, 0, stream>>>((bf16*)(ws + WS_DBG_B), 8192, 4, 1024, a.in[13], 512);
        k_headnorm<<<T * 4 / 4, 256, 0, stream>>>((bf16*)(ws + WS_DBG_A), 4096, 4, 1024, a.in[12], T);
        k_memattn<<<dim3(T / 8, 4), 256, 0, stream>>>((bf16*)(ws + WS_DBG_A), (const bf16*)(ws + WS_DBG_B));
#endif
        if (!(FAST_FLAGS & 1)) {
        k_headnorm<<<512 * 4 / 4, 256, 0, stream>>>((bf16*)(ws + WS_KVM), 8192, 4, 1024, a.in[13], 512);
        k_headnorm<<<T * 4 / 4, 256, 0, stream>>>((bf16*)(ws + WS_MQ), 4096, 4, 1024, a.in[12], T);
        k_memattn<<<dim3(T / 8, 4), 256, 0, stream>>>((bf16*)(ws + WS_MQ), (const bf16*)(ws + WS_KVM));
        }
    }
    launch(PH_PREP, PH_PREP + 1);
    launch(PH_MIX, PH_MIX + 1);
    launch(PH_MIX2, PH_MIX2 + 1);
#if DIFFTEST == 1
    dbg::k_diff<<<2048, 256, 0, stream>>>((const bf16*)(ws + WS_MQ), (const bf16*)(ws + WS_DBG_A), (size_t)T * 4096, (float*)(ws + WS_CTL) + 64);
#elif DIFFTEST == 2
    dbg::k_diff<<<2048, 256, 0, stream>>>((const bf16*)(ws + WS_SQ), (const bf16*)(ws + WS_DBG_A), (size_t)T * 4096, (float*)(ws + WS_CTL) + 64);
#elif DIFFTEST == 3
    dbg::k_diff<<<2048, 256, 0, stream>>>((const bf16*)(ws + WS_GV), (const bf16*)(ws + WS_DBG_A), (size_t)T * 4096, (float*)(ws + WS_CTL) + 64);
#endif
    launch(PH_MERGE, PH_MERGE + 1);
    launch(PH_WOUT, PH_WOUT + 1);
    launch(PH_HN, PH_HN + 1);
    launch(PH_PQ, PH_PQ + 1);
    launch(PH_TOPK, PH_TOPK + 1);
    launch(PH_PEER1, PH_PEER1 + 1);
    launch(PH_PEER2, PH_PEER2 + 1);
#endif
#if DIFFTEST
    dbg::k_scale<<<2048, 256, 0, stream>>>((float*)d_out, (size_t)T * 4096, (const float*)(ws + WS_CTL) + 64, 10.0f);
#endif
}
```
